# Optimizing an MI355X kernel written in HIP

```python
import math
import jax, jax.numpy as jnp
from jax import lax
import numpy as np

D_MODEL = 2048
BATCH = 16
SEQ = 256
DEPTH = 2
DEC_BATCH = 8
DEC_SEQ = 1024
PAST_LEN = 256

GRID_W = 64
EPS = 1e-6
HY_CH = 512
HY_ORDER = 2
HY_SHORT = 3
HY_BANDS = 16
HY_EMB = 1 + 2 * HY_BANDS
HY_FF = 64
HY_FAST_DECAY = 0.3
HY_SLOW_DECAY = 1.5
HY_TARGET = 1e-2
HY_W3_STD = 0.1 * HY_FF ** -0.5
HY_IN = 3 * HY_CH
GLA_HEADS = 4
GLA_DK = 64
GLA_DV = 128
GLA_LOWRANK = 16
GLA_TAU = 16.0
GLA_CHUNK = 64
GLA_QK = GLA_HEADS * GLA_DK
GLA_VW = GLA_HEADS * GLA_DV
GLA_IN = 2 * GLA_QK + 2 * GLA_VW + 2 * GLA_LOWRANK
MLA_HEADS = 8
MLA_Q_RANK = 384
MLA_KV_RANK = 256
MLA_NOPE = 128
MLA_ROPE = 64
MLA_V = 128
MLA_IN = MLA_Q_RANK + MLA_KV_RANK + MLA_ROPE
ROPE_THETA = 10000.0
Q_BLOCK = 128
D_IN = HY_IN + GLA_IN + MLA_IN
MIX_W = HY_CH + GLA_VW + MLA_HEADS * MLA_V
D_FF = -(-8 * D_MODEL // (3 * 256)) * 256

kernel_name = 'hybrid_hyena_gla_mla_prefix_dit_step'


def _split(t, sizes):
    pts = [int(p) for p in np.cumsum(sizes)[:-1]]
    return jnp.split(t, pts, axis=-1)


def rms_norm(x, g):
    xf = x.astype(jnp.float32)
    y = xf * lax.rsqrt(jnp.mean(xf * xf, axis=-1, keepdims=True) + EPS)
    return (y * g.astype(jnp.float32)).astype(x.dtype)


def short_conv(u, w, b):
    L = u.shape[1]
    p = HY_SHORT // 2
    up = jnp.pad(u, ((0, 0), (p, p), (0, 0)))
    return sum(up[:, i:i + L] * w[i] for i in range(HY_SHORT)) + b


def hyena_filters(L, w1, b1, freq, w2, b2, w3):
    t = jnp.linspace(0.0, 1.0, L, dtype=jnp.float32)[:, None]
    w = 2.0 * math.pi * jnp.arange(L, dtype=jnp.float32)[:, None] / L
    f = jnp.linspace(1e-4, HY_BANDS - 1, HY_BANDS, dtype=jnp.float32)
    z = jnp.concatenate([t, jnp.cos(f * w), -jnp.sin(f * w)], axis=-1)
    h = jnp.sin(freq[0] * (z @ w1 + b1))
    h = jnp.sin(freq[1] * (h @ w2 + b2))
    h = (h @ w3).astype(jnp.float32).reshape(L, 2, HY_ORDER, HY_CH)
    min_decay = math.log(HY_TARGET) / HY_SLOW_DECAY
    max_decay = math.log(HY_TARGET) / HY_FAST_DECAY
    delta = jnp.abs(jnp.linspace(min_decay, max_decay, HY_CH, dtype=jnp.float32))
    h = h * jnp.exp(-t[:, :, None, None] * delta)
    k_fwd, k_bwd = h[:, 0], h[:, 1]
    zero = jnp.zeros((1, HY_ORDER, HY_CH), jnp.float32)
    return jnp.concatenate([k_fwd, zero, k_bwd[1:][::-1]], axis=0)


def hyena_mixer(u, conv_w, conv_b, w1, b1, freq, w2, b2, w3, skip):
    L = u.shape[1]
    uc = short_conv(u, conv_w, conv_b).astype(jnp.float32)
    v, x1, x2 = jnp.split(uc, 3, axis=-1)
    k_f = jnp.fft.rfft(hyena_filters(L, w1, b1, freq, w2, b2, w3), n=2 * L, axis=0)
    z = v
    for o, gate in enumerate((x1, x2)):
        z_f = jnp.fft.rfft(z, n=2 * L, axis=1)
        conv = jnp.fft.irfft(z_f * k_f[:, o], n=2 * L, axis=1)[:, :L]
        z = gate * (conv + z * skip[o].astype(jnp.float32))
    return z.astype(u.dtype)


def gla_chunked(q, k, v, log_a, s0):
    B, H, L, dk = q.shape
    dv = v.shape[-1]
    n = L // GLA_CHUNK
    def chunks(t):
        return t.reshape(B, H, n, GLA_CHUNK, t.shape[-1])
    q, k, v, log_a = chunks(q), chunks(k), chunks(v), chunks(log_a)
    cum = jnp.cumsum(log_a, axis=3)
    total = cum[:, :, :, -1]
    q_dec = q * jnp.exp(cum)
    k_inv = k * jnp.exp(-cum)
    k_end = k * jnp.exp(total[:, :, :, None] - cum)
    mask = jnp.tril(jnp.ones((GLA_CHUNK, GLA_CHUNK), dtype=bool))
    att = jnp.where(mask, jnp.einsum('bhncd,bhnsd->bhncs', q_dec, k_inv), 0.0)
    o_intra = jnp.einsum('bhncs,bhnse->bhnce', att, v)
    kv_chunk = jnp.einsum('bhncd,bhnce->bhnde', k_end, v)
    def step(s, inp):
        qd, dec, kvc = inp
        o = jnp.einsum('bhcd,bhde->bhce', qd, s)
        return dec[..., None] * s + kvc, o
    xs = (jnp.moveaxis(q_dec, 2, 0), jnp.moveaxis(jnp.exp(total), 2, 0), jnp.moveaxis(kv_chunk, 2, 0))
    s_fin, o_inter = lax.scan(step, s0, xs)
    o = o_intra + jnp.moveaxis(o_inter, 0, 2)
    return o.reshape(B, H, L, dv), s_fin


def gla_mixer(u, s0f, s0b, wa_f, ba_f, wa_b, ba_b, norm_g):
    B, L, _ = u.shape
    q, k, v, g, af, ab = _split(u, (GLA_QK, GLA_QK, GLA_VW, GLA_VW, GLA_LOWRANK, GLA_LOWRANK))
    def heads(t, d):
        return t.reshape(B, L, GLA_HEADS, d).transpose(0, 2, 1, 3).astype(jnp.float32)
    q = heads(q, GLA_DK) * GLA_DK ** -0.5
    k = heads(k, GLA_DK)
    v = heads(v, GLA_DV)
    la_f = heads(jax.nn.log_sigmoid((af @ wa_f + ba_f).astype(jnp.float32)), GLA_DK) / GLA_TAU
    la_b = heads(jax.nn.log_sigmoid((ab @ wa_b + ba_b).astype(jnp.float32)), GLA_DK) / GLA_TAU
    o_f, s_f = gla_chunked(q, k, v, la_f, s0f.astype(jnp.float32))
    def flip(t):
        return t[:, :, ::-1]
    o_b, s_b = gla_chunked(flip(q), flip(k), flip(v), flip(la_b), s0b.astype(jnp.float32))
    o = rms_norm(o_f + flip(o_b), norm_g)
    o = o.transpose(0, 2, 1, 3).reshape(B, L, GLA_VW) * jax.nn.silu(g.astype(jnp.float32))
    return o.astype(u.dtype), s_f, s_b


def axial_rope(x):
    L = x.shape[1]
    rows = L // GRID_W
    row = jnp.repeat(jnp.arange(rows), GRID_W)
    col = jnp.tile(jnp.arange(GRID_W), rows)
    half = MLA_ROPE // 2
    inv = ROPE_THETA ** (-jnp.arange(0, half, 2, dtype=jnp.float32) / half)
    extra = (1,) * (x.ndim - 3)
    def rot(xa, pos):
        ang = (pos.astype(jnp.float32)[:, None] * inv).reshape((L,) + extra + (half // 2,))
        cos, sin = jnp.cos(ang), jnp.sin(ang)
        x1, x2 = jnp.split(xa.astype(jnp.float32), 2, axis=-1)
        return jnp.concatenate([x1 * cos - x2 * sin, x1 * sin + x2 * cos], axis=-1)
    return jnp.concatenate([rot(x[..., :half], row), rot(x[..., half:], col)], axis=-1).astype(x.dtype)


def mla_attend(q_nope, q_rope, k_nope, k_rope, v):
    B, Lq, H, _ = q_nope.shape
    nb = Lq // Q_BLOCK
    scale = (MLA_NOPE + MLA_ROPE) ** -0.5
    def blocks(t):
        return jnp.moveaxis(t.reshape((B, nb, Q_BLOCK) + t.shape[2:]), 1, 0)
    def one_block(qs):
        qn, qr = qs
        s = jnp.einsum('bqhd,bkhd->bhqk', qn, k_nope) + jnp.einsum('bqhd,bkd->bhqk', qr, k_rope)
        p = jax.nn.softmax(s.astype(jnp.float32) * scale, axis=-1).astype(v.dtype)
        return jnp.einsum('bhqk,bkhd->bqhd', p, v)
    out = lax.map(one_block, (blocks(q_nope), blocks(q_rope)))
    return jnp.moveaxis(out, 0, 1).reshape(B, Lq, H * MLA_V)


def mla_mixer(u, q_norm, w_uq, kv_norm, w_ukv, ctx=None):
    B, L, _ = u.shape
    cq, ckv, krope = _split(u, (MLA_Q_RANK, MLA_KV_RANK, MLA_ROPE))
    q = (rms_norm(cq, q_norm) @ w_uq).reshape(B, L, MLA_HEADS, MLA_NOPE + MLA_ROPE)
    q_nope, q_rope = q[..., :MLA_NOPE], q[..., MLA_NOPE:]
    ckv = rms_norm(ckv, kv_norm)
    if ctx is None:
        keys_ckv, keys_rope = ckv, krope
    else:
        ctx_ckv, ctx_krope = ctx
        q_rope = axial_rope(q_rope)
        keys_ckv = jnp.concatenate([ckv, ctx_ckv.astype(ckv.dtype)], axis=1)
        keys_rope = jnp.concatenate([axial_rope(krope), ctx_krope.astype(krope.dtype)], axis=1)
    Lk = keys_ckv.shape[1]
    kv = (keys_ckv @ w_ukv).reshape(B, Lk, MLA_HEADS, MLA_NOPE + MLA_V)
    k_nope, v = kv[..., :MLA_NOPE], kv[..., MLA_NOPE:]
    return mla_attend(q_nope, q_rope, k_nope, keys_rope, v), ckv, krope


def trunk_layer(x, mod, lp, ctx=None):
    B = x.shape[0]
    sh1, sc1, g1, sh2, sc2, g2 = [m[:, None] for m in jnp.split(mod, 6, axis=-1)]
    h = rms_norm(x, lp['ln_mix']) * (1.0 + sc1) + sh1
    u_hy, u_gla, u_mla = _split(h @ lp['w_in'], (HY_IN, GLA_IN, MLA_IN))
    y_hy = hyena_mixer(u_hy, lp['hy_conv_w'], lp['hy_conv_b'], lp['hy_filt_w1'], lp['hy_filt_b1'],
                       lp['hy_filt_freq'], lp['hy_filt_w2'], lp['hy_filt_b2'], lp['hy_filt_w3'], lp['hy_skip'])
    if ctx is None:
        s0 = jnp.zeros((B, GLA_HEADS, GLA_DK, GLA_DV), jnp.float32)
        s0f, s0b, mla_ctx = s0, s0, None
    else:
        ctx_ckv, ctx_krope, s0f, s0b = ctx
        mla_ctx = (ctx_ckv, ctx_krope)
    y_gla, s_f, s_b = gla_mixer(u_gla, s0f, s0b, lp['gla_wa_f'], lp['gla_ba_f'], lp['gla_wa_b'],
                                lp['gla_ba_b'], lp['gla_norm'])
    y_mla, ckv, krope = mla_mixer(u_mla, lp['mla_q_norm'], lp['mla_w_uq'], lp['mla_kv_norm'],
                                  lp['mla_w_ukv'], mla_ctx)
    y = jnp.concatenate([y_hy, y_gla.astype(y_hy.dtype), y_mla.astype(y_hy.dtype)], axis=-1) @ lp['w_out']
    x = x + g1 * y
    h = rms_norm(x, lp['ln_ffn']) * (1.0 + sc2) + sh2
    gate, up = jnp.split(h @ lp['w_ffn_in'], 2, axis=-1)
    x = x + g2 * ((jax.nn.silu(gate) * up) @ lp['w_ffn_out'])
    return x, ((ckv, krope, s_f, s_b) if ctx is None else None)


def setup_inputs(seed: int = 0) -> dict:
    key = jax.random.key(seed)
    ks = iter(jax.random.split(key, 48))
    def nrm(shape, s):
        return jax.random.normal(next(ks), shape, jnp.float32) * s
    def gain(shape):
        return 1.0 + nrm(shape, 0.02)
    return {
        'x_prompt': nrm((BATCH, SEQ, D_MODEL), 1.0),
        'x_sample': nrm((DEC_BATCH, DEC_SEQ, D_MODEL), 1.0),
        'cache_mla_ckv': nrm((DEC_BATCH, DEPTH, PAST_LEN, MLA_KV_RANK), 1.0),
        'cache_mla_krope': nrm((DEC_BATCH, DEPTH, PAST_LEN, MLA_ROPE), 1.0),
        'state_gla_fwd': nrm((DEC_BATCH, DEPTH, GLA_HEADS, GLA_DK, GLA_DV), 2.0),
        'state_gla_bwd': nrm((DEC_BATCH, DEPTH, GLA_HEADS, GLA_DK, GLA_DV), 2.0),
        'c': nrm((DEC_BATCH, D_MODEL), 1.0),
        'c_ctx': nrm((D_MODEL,), 1.0),
        'w_mod': nrm((DEPTH, D_MODEL, 6 * D_MODEL), 0.5 * D_MODEL ** -0.5),
        'b_mod': nrm((DEPTH, 6 * D_MODEL), 0.02),
        'ln_mix': gain((DEPTH, D_MODEL)),
        'w_in': nrm((DEPTH, D_MODEL, D_IN), D_MODEL ** -0.5),
        'hy_conv_w': nrm((DEPTH, HY_SHORT, HY_IN), HY_SHORT ** -0.5),
        'hy_conv_b': nrm((DEPTH, HY_IN), 0.02),
        'hy_filt_w1': nrm((DEPTH, HY_EMB, HY_FF), HY_EMB ** -0.5),
        'hy_filt_b1': nrm((DEPTH, HY_FF), 0.1),
        'hy_filt_freq': gain((DEPTH, 2, HY_FF)),
        'hy_filt_w2': nrm((DEPTH, HY_FF, HY_FF), HY_FF ** -0.5),
        'hy_filt_b2': nrm((DEPTH, HY_FF), 0.1),
        'hy_filt_w3': nrm((DEPTH, HY_FF, 2 * HY_ORDER * HY_CH), HY_W3_STD),
        'hy_skip': nrm((DEPTH, HY_ORDER, HY_CH), 0.5),
        'gla_wa_f': nrm((DEPTH, GLA_LOWRANK, GLA_QK), GLA_LOWRANK ** -0.5),
        'gla_ba_f': nrm((DEPTH, GLA_QK), 0.02),
        'gla_wa_b': nrm((DEPTH, GLA_LOWRANK, GLA_QK), GLA_LOWRANK ** -0.5),
        'gla_ba_b': nrm((DEPTH, GLA_QK), 0.02),
        'gla_norm': gain((DEPTH, GLA_DV)),
        'mla_q_norm': gain((DEPTH, MLA_Q_RANK)),
        'mla_w_uq': nrm((DEPTH, MLA_Q_RANK, MLA_HEADS * (MLA_NOPE + MLA_ROPE)), MLA_Q_RANK ** -0.5),
        'mla_kv_norm': gain((DEPTH, MLA_KV_RANK)),
        'mla_w_ukv': nrm((DEPTH, MLA_KV_RANK, MLA_HEADS * (MLA_NOPE + MLA_V)), MLA_KV_RANK ** -0.5),
        'w_out': nrm((DEPTH, MIX_W, D_MODEL), MIX_W ** -0.5),
        'ln_ffn': gain((DEPTH, D_MODEL)),
        'w_ffn_in': nrm((DEPTH, D_MODEL, 2 * D_FF), D_MODEL ** -0.5),
        'w_ffn_out': nrm((DEPTH, D_FF, D_MODEL), D_FF ** -0.5),
        'ln_final': gain((D_MODEL,)),
    }


def reference(x_prompt, x_sample, cache_mla_ckv, cache_mla_krope, state_gla_fwd, state_gla_bwd, c, c_ctx,
              w_mod, b_mod, ln_mix, w_in, hy_conv_w, hy_conv_b, hy_filt_w1, hy_filt_b1, hy_filt_freq,
              hy_filt_w2, hy_filt_b2, hy_filt_w3, hy_skip, gla_wa_f, gla_ba_f, gla_wa_b, gla_ba_b, gla_norm,
              mla_q_norm, mla_w_uq, mla_kv_norm, mla_w_ukv, w_out, ln_ffn, w_ffn_in, w_ffn_out, ln_final):
    x_ctx, x_lat = x_prompt, x_sample
    ckv_l, krope_l, sf_l, sb_l = [], [], [], []
    for l in range(DEPTH):
        lp = {
            'ln_mix': ln_mix[l], 'w_in': w_in[l],
            'hy_conv_w': hy_conv_w[l], 'hy_conv_b': hy_conv_b[l],
            'hy_filt_w1': hy_filt_w1[l], 'hy_filt_b1': hy_filt_b1[l], 'hy_filt_freq': hy_filt_freq[l],
            'hy_filt_w2': hy_filt_w2[l], 'hy_filt_b2': hy_filt_b2[l], 'hy_filt_w3': hy_filt_w3[l],
            'hy_skip': hy_skip[l],
            'gla_wa_f': gla_wa_f[l], 'gla_ba_f': gla_ba_f[l], 'gla_wa_b': gla_wa_b[l], 'gla_ba_b': gla_ba_b[l],
            'gla_norm': gla_norm[l],
            'mla_q_norm': mla_q_norm[l], 'mla_w_uq': mla_w_uq[l], 'mla_kv_norm': mla_kv_norm[l],
            'mla_w_ukv': mla_w_ukv[l],
            'w_out': w_out[l], 'ln_ffn': ln_ffn[l], 'w_ffn_in': w_ffn_in[l], 'w_ffn_out': w_ffn_out[l],
        }
        mod_ctx = jax.nn.silu(c_ctx)[None] @ w_mod[l] + b_mod[l]
        mod_lat = jax.nn.silu(c) @ w_mod[l] + b_mod[l]
        x_ctx, (ckv, krope, s_f, s_b) = trunk_layer(x_ctx, mod_ctx, lp)
        ckv_l.append(ckv)
        krope_l.append(krope)
        sf_l.append(s_f)
        sb_l.append(s_b)
        ctx = (cache_mla_ckv[:, l], cache_mla_krope[:, l], state_gla_fwd[:, l], state_gla_bwd[:, l])
        x_lat, _ = trunk_layer(x_lat, mod_lat, lp, ctx)
    y_prompt = rms_norm(x_ctx, ln_final)
    y_sample = rms_norm(x_lat, ln_final)
    new_mla_ckv = jnp.stack(ckv_l, axis=1)
    new_mla_krope = jnp.stack(krope_l, axis=1)
    new_gla_fwd = jnp.stack(sf_l, axis=1)
    new_gla_bwd = jnp.stack(sb_l, axis=1)
    return (y_prompt, y_sample, new_mla_ckv, new_mla_krope, new_gla_fwd, new_gla_bwd)
```

```cpp
#include <hip/hip_runtime.h>
#include <hip/hip_cooperative_groups.h>
#include <cstdio>
#include <cstdint>
namespace cg = cooperative_groups;

#define LAS __attribute__((address_space(3)))
typedef unsigned short bf16_t;
typedef short bf16x8 __attribute__((ext_vector_type(8)));
typedef short s16x4 __attribute__((ext_vector_type(4)));
typedef float f32x4 __attribute__((ext_vector_type(4)));
typedef float f32x2 __attribute__((ext_vector_type(2)));
typedef float f32x16 __attribute__((ext_vector_type(16)));
typedef unsigned u32x4 __attribute__((ext_vector_type(4)));
typedef unsigned u32x2 __attribute__((ext_vector_type(2)));

constexpr int DM = 2048, MC = 4096, ML = 8192, MT = MC + ML;
constexpr int NMOD = 6 * DM;
constexpr int DFF = 5632;
constexpr int NT_ = 2304, NN_ = 1792;
constexpr int MKV = MT + 2048;
constexpr float EPS = 1e-6f;
constexpr int UN_Q = 0, UN_K = 256, UN_G = 512, UN_CQ = 1024, UN_CKV = 1408, UN_KR = 1664, UN_AF = 1728, UN_AB = 1744;
constexpr int UT_HY = 0, UT_GK = 1536, UT_GV = 1792;
constexpr size_t O_Y = 0, O_CKV = (size_t)MT * DM, O_KR = O_CKV + 2097152, O_GF = O_KR + 524288, O_GB = O_GF + 1048576;

constexpr size_t al(size_t x) { return (x + 255) & ~(size_t)255; }
constexpr size_t WS_MOD = 0;
constexpr size_t WS_WINT = al(WS_MOD + 2 * 9 * NMOD * 4);
constexpr size_t WS_WINN = al(WS_WINT + (size_t)2 * NT_ * DM * 2);
constexpr size_t WS_WUQ = al(WS_WINN + (size_t)2 * NN_ * DM * 2);
constexpr size_t WS_WUK = al(WS_WUQ + (size_t)2 * 1536 * 384 * 2);
constexpr size_t WS_WUV = al(WS_WUK + (size_t)2 * 1024 * 256 * 2);
constexpr size_t WS_WOUT = al(WS_WUV + (size_t)2 * 1024 * 256 * 2);
constexpr size_t WS_WF1 = al(WS_WOUT + (size_t)2 * DM * DM * 2);
constexpr size_t WS_WF2 = al(WS_WF1 + (size_t)2 * 2 * DFF * DM * 2);
constexpr size_t WS_HF = al(WS_WF2 + (size_t)2 * DM * DFF * 2);
constexpr size_t HF_L = (size_t)2 * 512 * 512 + (size_t)2 * 512 * 2048;
constexpr size_t WS_XN = al(WS_HF + 2 * HF_L * 4);
constexpr size_t WS_CKVN = al(WS_XN + (size_t)MT * DM * 2);
constexpr size_t WS_KRB = al(WS_CKVN + (size_t)2 * MKV * 256 * 2);
constexpr size_t WS_YMIX = al(WS_KRB + (size_t)2 * MKV * 64 * 2);
constexpr size_t WS_X1 = al(WS_YMIX + (size_t)MT * DM * 2);
constexpr size_t WS_X2 = al(WS_X1 + (size_t)MT * DM * 4);
constexpr size_t WS_UT = al(WS_X2 + (size_t)MT * DM * 4);
constexpr size_t WS_UN = al(WS_UT + (size_t)NT_ * MT * 2);
constexpr size_t WS_CQN = al(WS_UN + (size_t)MT * NN_ * 2);
constexpr size_t WS_Q = al(WS_CQN + (size_t)MT * 384 * 2);
constexpr size_t WS_KN = al(WS_Q + (size_t)MT * 1536 * 2);
constexpr size_t WS_VT = al(WS_KN + (size_t)MKV * 1024 * 2);
constexpr size_t WS_OF = al(WS_VT + (size_t)1024 * MKV * 2);
constexpr size_t WS_OB = al(WS_OF + (size_t)MT * 512 * 4);
constexpr size_t WS_MIXEND = al(WS_OB + (size_t)MT * 512 * 4);
constexpr size_t WS_H = WS_UT;
constexpr size_t WS_END = WS_MIXEND;
static_assert(WS_H + (size_t)MT * DFF * 2 <= WS_MIXEND, "H overlay fits");

constexpr int LDS_BYTES = 147456;

__device__ __forceinline__ float bf2f(bf16_t v) { return __uint_as_float((unsigned)v << 16); }
__device__ __forceinline__ unsigned f2bf(float f) { unsigned u = __float_as_uint(f); return (u + 0x7fffu + ((u >> 16) & 1u)) >> 16; }
__device__ __forceinline__ unsigned pk2(float lo, float hi) { return f2bf(lo) | (f2bf(hi) << 16); }
__device__ __forceinline__ float lo16(unsigned w) { return __uint_as_float(w << 16); }
__device__ __forceinline__ float hi16(unsigned w) { return __uint_as_float(w & 0xffff0000u); }
__device__ __forceinline__ float wave_sum(float v) {
#pragma unroll
    for (int o = 1; o < 64; o <<= 1) v += __shfl_xor(v, o);
    return v;
}
__device__ __forceinline__ float sin_turns(float t) { return __builtin_amdgcn_sinf(t); }
__device__ __forceinline__ float cos_turns(float t) { return __builtin_amdgcn_cosf(t); }
__device__ __forceinline__ float sin_rad(float x) { float t = x * 0.15915494309189535f; t -= floorf(t); return __builtin_amdgcn_sinf(t); }
__device__ __forceinline__ float siluf(float x) { return x / (1.f + __expf(-x)); }

namespace pg8 {
constexpr int BM = 256, BK = 64, HALF = 128, HTB = HALF * BK * 2, STAGE_BYTES = 8 * HTB, NXCD = 8, WGM = 8;
__host__ __device__ __forceinline__ int lds_byte(int r, int c) { const int st = (r >> 4) * 2 + (c >> 5), rr = r & 15, cc = c & 31, ob = rr * 64 + cc * 2; return st * 1024 + (ob ^ (((ob >> 9) & 1) << 5)); }
__host__ __device__ __forceinline__ void stage_rc(int b, int& R, int& C) { const int st = b / 1024, sb = b % 1024, swz = sb ^ (((sb >> 9) & 1) << 5); R = (st >> 1) * 16 + swz / 64; C = (st & 1) * 32 + (swz % 64) / 2; }
__host__ __device__ __forceinline__ int perm32(int rho) { const int n = rho >> 4, i = rho & 15; return 8 * (i >> 2) + 4 * n + (i & 3); }

struct Unit { int pm, pn, gi; };
struct Gemms { const bf16_t* A0; const bf16_t* B0; const bf16_t* A1; const bf16_t* B1; int K; };

struct MultiOrder {
    int nM0, nN0, nM1, nN1, n0, nwg, G, c;
    __device__ __forceinline__ void init(int G_, int c_, int M0, int N0, int M1, int N1) { G = G_; c = c_; nM0 = M0 / BM; nN0 = N0 / BM; nM1 = M1 / BM; nN1 = N1 / BM; n0 = nM0 * nN0; nwg = n0 + nM1 * nN1; }
    __device__ __forceinline__ bool next(int i, Unit& u) const {
        const long L = (long)i * G + c; if (L >= nwg) return false;
        int wgid = (int)L; { const int q = nwg / NXCD, r = nwg % NXCD, xcd = wgid % NXCD, o = wgid / NXCD; wgid = (xcd < r ? xcd * (q + 1) : r * (q + 1) + (xcd - r) * q) + o; }
        const int s = wgid >= n0 ? 1 : 0;
        const int loc = wgid - (s ? n0 : 0);
        const int nm = s ? nM1 : nM0, nn = s ? nN1 : nN0;
        const int nig = WGM * nn, gid = loc / nig, fm = gid * WGM, gsz = (nm - fm) < WGM ? (nm - fm) : WGM;
        u.pm = fm + ((loc % nig) % gsz); u.pn = (loc % nig) / gsz; u.gi = s; return true;
    }
};

__device__ __forceinline__ unsigned cvt_pk_bf16(float lo, float hi) { unsigned r; asm volatile("v_cvt_pk_bf16_f32 %0, %1, %2" : "=v"(r) : "v"(lo), "v"(hi)); return r; }

struct EpiStore {
    static constexpr bool PERM = true;
    bf16_t* O0; bf16_t* O1; int ld0, ld1;
    __device__ __forceinline__ void operator()(const f32x4 (&acc)[2][2][4][2], const Unit& u, int wr, int wc, int fr, int fq) const {
        bf16_t* base = u.gi >= 1 ? O1 : O0; const int ld = u.gi >= 1 ? ld1 : ld0;
        const int row0 = u.pm * BM + wr * 64 + fr, col0 = u.pn * BM + wc * 32 + 8 * fq;
#pragma unroll
        for (int ai = 0; ai < 2; ++ai)
#pragma unroll
            for (int m = 0; m < 4; ++m) { bf16_t* rowp = base + (size_t)(row0 + ai * HALF + m * 16) * ld + col0;
#pragma unroll
                for (int bj = 0; bj < 2; ++bj) { const f32x4 v0 = acc[ai][bj][m][0], v1 = acc[ai][bj][m][1];
                    u32x4 w; w.x = cvt_pk_bf16(v0[0], v0[1]); w.y = cvt_pk_bf16(v0[2], v0[3]); w.z = cvt_pk_bf16(v1[0], v1[1]); w.w = cvt_pk_bf16(v1[2], v1[3]);
                    *(u32x4*)(rowp + bj * HALF) = w; } }
    }
};
struct EpiSwiGLU {
    static constexpr bool PERM = true;
    bf16_t* O;
    __device__ __forceinline__ void operator()(const f32x4 (&acc)[2][2][4][2], const Unit& u, int wr, int wc, int fr, int fq) const {
        const int row0 = u.pm * BM + wr * 64 + fr, col0 = u.pn * HALF + wc * 32 + 8 * fq;
#pragma unroll
        for (int ai = 0; ai < 2; ++ai)
#pragma unroll
            for (int m = 0; m < 4; ++m) { bf16_t* rowp = O + (size_t)(row0 + ai * HALF + m * 16) * DFF + col0;
                float h[8];
#pragma unroll
                for (int n = 0; n < 2; ++n)
#pragma unroll
                    for (int e = 0; e < 4; ++e) { const float g = acc[ai][0][m][n][e], up = acc[ai][1][m][n][e]; h[n * 4 + e] = g * __builtin_amdgcn_rcpf(1.f + __expf(-g)) * up; }
                u32x4 w; w.x = cvt_pk_bf16(h[0], h[1]); w.y = cvt_pk_bf16(h[2], h[3]); w.z = cvt_pk_bf16(h[4], h[5]); w.w = cvt_pk_bf16(h[6], h[7]);
                *(u32x4*)rowp = w; }
    }
};
struct EpiResGate {
    static constexpr bool PERM = false;
    const float* base0; const float* base1; int split; float* out; const float* mod; int goff;
    __device__ __forceinline__ void operator()(const f32x4 (&acc)[2][2][4][2], const Unit& u, int wr, int wc, int fr, int fq) const {
        const int r9 = u.pm < 16 ? 8 : ((u.pm - 16) >> 2);
        const float* gate = mod + (size_t)r9 * NMOD + goff;
        const int row0 = u.pm * BM + wr * 64 + fr, col0 = u.pn * BM + wc * 32 + 4 * fq;
        f32x4 gv[2][2];
#pragma unroll
        for (int bj = 0; bj < 2; ++bj)
#pragma unroll
            for (int n = 0; n < 2; ++n) gv[bj][n] = *(const f32x4*)(gate + col0 + bj * HALF + n * 16);
#pragma unroll
        for (int ai = 0; ai < 2; ++ai)
#pragma unroll
            for (int m = 0; m < 4; ++m) { const int row = row0 + ai * HALF + m * 16;
                const float* bp = (row < split ? base0 + (size_t)row * DM : base1 + (size_t)(row - split) * DM) + col0; float* op = out + (size_t)row * DM + col0;
#pragma unroll
                for (int bj = 0; bj < 2; ++bj)
#pragma unroll
                    for (int n = 0; n < 2; ++n) { const f32x4 b = *(const f32x4*)(bp + bj * HALF + n * 16); *(f32x4*)(op + bj * HALF + n * 16) = b + gv[bj][n] * acc[ai][bj][m][n]; } }
    }
};

template <class Epi, class Sched>
__device__ __forceinline__ void gemm_phase(LAS unsigned char* lds, const Gemms g, const Sched& S, const Epi& E) {
    int tid_ = threadIdx.x; asm volatile("" : "+v"(tid_));
    const int tid = tid_, wid = __builtin_amdgcn_readfirstlane(tid >> 6), lane = tid & 63, wr = wid >> 2, wc = wid & 3, fr = lane & 15, fq = lane >> 4;
    const int K = g.K, nt = K / BK;
    unsigned voffA[2], voffB[2];
#pragma unroll
    for (int i = 0; i < 2; ++i) { int R, C; stage_rc(tid * 16 + i * 8192, R, C); const int Rb = Epi::PERM ? ((R & ~31) + perm32(R & 31)) : R;
        voffA[i] = (unsigned)(R * K + C) * 2u; voffB[i] = (unsigned)(Rb * K + C) * 2u; }
    const size_t kstep = (size_t)(BK * 2);
    const size_t hstep = (size_t)HALF * K * 2;
    const size_t tstep = 2 * hstep;
    const unsigned ldsw = (unsigned)wid * 1024u;
    const int aoff = lds_byte(wr * 64 + fr, fq * 8), boff = lds_byte(wc * 32 + fr, fq * 8);
#define PG8_SA(b, h) (((b) * 2 + (h)) * HTB)
#define PG8_SB(b, h) ((4 + (b) * 2 + (h)) * HTB)
#define PG8_STAGE(bufoff, gbase, voff) do { _Pragma("unroll") for (int _i = 0; _i < 2; ++_i) \
        __builtin_amdgcn_global_load_lds((const unsigned*)((const char*)(gbase) + (voff)[_i]), (LAS unsigned*)(lds + (bufoff) + ldsw + _i * 8192), 16, 0, 0); } while (0)
#define PG8_LDA(dst, b, h) do { _Pragma("unroll") for (int m = 0; m < 4; ++m) _Pragma("unroll") for (int k = 0; k < 2; ++k) dst[m][k] = *(const LAS bf16x8*)(lds + PG8_SA(b, h) + aoff + m * 2048 + k * 1024); } while (0)
#define PG8_LDB(dst, b, h) do { _Pragma("unroll") for (int n = 0; n < 2; ++n) _Pragma("unroll") for (int k = 0; k < 2; ++k) dst[n][k] = *(const LAS bf16x8*)(lds + PG8_SB(b, h) + boff + n * 2048 + k * 1024); } while (0)
#define PG8_MMA(ai, bj, At, Bt) do { __builtin_amdgcn_s_setprio(1); _Pragma("unroll") for (int m = 0; m < 4; ++m) _Pragma("unroll") for (int n = 0; n < 2; ++n) _Pragma("unroll") for (int k = 0; k < 2; ++k) \
        acc[ai][bj][m][n] = __builtin_amdgcn_mfma_f32_16x16x32_bf16(Bt[n][k], At[m][k], acc[ai][bj][m][n], 0, 0, 0); __builtin_amdgcn_s_setprio(0); } while (0)
#define PG8_WAIT_V(n) asm volatile("s_waitcnt vmcnt(" #n ")" ::: "memory")
#define PG8_WAIT_L(n) asm volatile("s_waitcnt lgkmcnt(" #n ")" ::: "memory")
#define PG8_BAR __builtin_amdgcn_s_barrier()
#define PG8_SCHED __builtin_amdgcn_sched_barrier(0)
#define PG8_ABASE(u) ((const char*)((u).gi >= 1 ? g.A1 : g.A0) + (size_t)(u).pm * tstep)
#define PG8_BBASE(u) ((const char*)((u).gi >= 1 ? g.B1 : g.B0) + (size_t)(u).pn * tstep)
    Unit cur, nxt; int ui = 0;
    if (!S.next(0, cur)) return;
    f32x4 acc[2][2][4][2];
#pragma unroll
    for (int a = 0; a < 2; ++a)
#pragma unroll
        for (int b = 0; b < 2; ++b)
#pragma unroll
            for (int m = 0; m < 4; ++m)
#pragma unroll
                for (int n = 0; n < 2; ++n) acc[a][b][m][n] = (f32x4){0.f, 0.f, 0.f, 0.f};
    bf16x8 At[4][2], B0[2][2], B1[2][2];
    const char* cA = PG8_ABASE(cur); const char* cB = PG8_BBASE(cur);
    PG8_STAGE(PG8_SB(0, 0), cB, voffB); PG8_STAGE(PG8_SB(0, 1), cB + hstep, voffB); PG8_STAGE(PG8_SA(0, 0), cA, voffA); PG8_STAGE(PG8_SA(0, 1), cA + hstep, voffA);
    if (wr == 1) PG8_BAR;
    PG8_WAIT_V(2); PG8_BAR;
    PG8_STAGE(PG8_SB(1, 0), cB + kstep, voffB); PG8_STAGE(PG8_SA(1, 0), cA + kstep, voffA); PG8_STAGE(PG8_SB(1, 1), cB + hstep + kstep, voffB);
    PG8_WAIT_V(6); PG8_BAR;
    for (;;) {
        const bool has_next = S.next(ui + 1, nxt);
        const char* nA = has_next ? PG8_ABASE(nxt) : cA; const char* nB = has_next ? PG8_BBASE(nxt) : cB;
        for (int t = 0; t < nt; t += 2) {
            const bool last = (t == nt - 2);
            const char* a1 = cA + (size_t)(t + 1) * kstep;
            const char* a2 = last ? nA : cA + (size_t)(t + 2) * kstep; const char* b2 = last ? nB : cB + (size_t)(t + 2) * kstep;
            const char* a3 = a2 + kstep; const char* b3 = b2 + kstep;
            PG8_LDB(B0, 0, 0); PG8_LDB(B1, 0, 1); PG8_SCHED; PG8_LDA(At, 0, 0); PG8_STAGE(PG8_SA(1, 1), a1 + hstep, voffA);
            PG8_WAIT_V(8); PG8_WAIT_L(0); PG8_BAR; PG8_MMA(0, 0, At, B0); PG8_MMA(0, 1, At, B1); PG8_BAR; PG8_SCHED;
            PG8_LDA(At, 0, 1); PG8_STAGE(PG8_SB(0, 0), b2, voffB); PG8_STAGE(PG8_SB(0, 1), b2 + hstep, voffB); PG8_STAGE(PG8_SA(0, 0), a2, voffA);
            PG8_WAIT_V(8); PG8_WAIT_L(0); PG8_BAR; PG8_MMA(1, 0, At, B0); PG8_MMA(1, 1, At, B1); PG8_BAR; PG8_SCHED;
            PG8_LDB(B0, 1, 0); PG8_LDB(B1, 1, 1); PG8_SCHED; PG8_LDA(At, 1, 0); PG8_STAGE(PG8_SA(0, 1), a2 + hstep, voffA);
            PG8_WAIT_V(8); PG8_WAIT_L(0); PG8_BAR; PG8_MMA(0, 0, At, B0); PG8_MMA(0, 1, At, B1); PG8_BAR; PG8_SCHED;
            PG8_LDA(At, 1, 1); PG8_STAGE(PG8_SB(1, 0), b3, voffB); PG8_STAGE(PG8_SB(1, 1), b3 + hstep, voffB); PG8_STAGE(PG8_SA(1, 0), a3, voffA);
            PG8_WAIT_V(8); PG8_WAIT_L(0); PG8_BAR; PG8_MMA(1, 0, At, B0); PG8_MMA(1, 1, At, B1); PG8_BAR; PG8_SCHED;
        }
        if (wr == 0) PG8_BAR;
        E(acc, cur, wr, wc, fr, fq);
        if (!has_next) break;
#pragma unroll
        for (int a = 0; a < 2; ++a)
#pragma unroll
            for (int b = 0; b < 2; ++b)
#pragma unroll
                for (int m = 0; m < 4; ++m)
#pragma unroll
                    for (int n = 0; n < 2; ++n) acc[a][b][m][n] = (f32x4){0.f, 0.f, 0.f, 0.f};
        cur = nxt; cA = nA; cB = nB; ++ui;
        if (wr == 1) PG8_BAR;
    }
    PG8_WAIT_V(0);
    PG8_BAR;
#undef PG8_SA
#undef PG8_SB
#undef PG8_STAGE
#undef PG8_LDA
#undef PG8_LDB
#undef PG8_MMA
#undef PG8_WAIT_V
#undef PG8_WAIT_L
#undef PG8_BAR
#undef PG8_SCHED
#undef PG8_ABASE
#undef PG8_BBASE
}
}

struct Args { const float* in[35]; float* out; unsigned char* ws; int pad0, pad1; };
enum { I_XP = 0, I_XS, I_CCKV, I_CKR, I_SGF, I_SGB, I_C, I_CCTX, I_WMOD, I_BMOD, I_LNMIX, I_WIN, I_HCW, I_HCB, I_HW1, I_HB1, I_HFREQ, I_HW2, I_HB2, I_HW3, I_HSKIP,
       I_WAF, I_BAF, I_WAB, I_BAB, I_GNORM, I_QNORM, I_WUQ, I_KVNORM, I_WUKV, I_WOUT, I_LNFFN, I_WF1, I_WF2, I_LNFIN };

struct Frame {
    LAS unsigned char* lds;
    int G, bid;
    const float* const* in; float* out; unsigned char* ws;
};
struct Ids { int tid, lane, wave; };
__device__ __forceinline__ Ids get_ids() { int t = threadIdx.x; asm volatile("" : "+v"(t)); Ids r; r.tid = t; r.lane = t & 63; r.wave = __builtin_amdgcn_readfirstlane(t >> 6); return r; }
#define WSP(T, off) ((T*)(F.ws + (off)))

__device__ __forceinline__ void transpose_item(const float* W, int ldn, int k0, int n0, bf16_t* WT, int ldk, int row0, LAS float* scr, int lane) {
    float v[32];
#pragma unroll
    for (int i = 0; i < 32; ++i) { const int kk = 2 * i + (lane >> 5); v[i] = W[(size_t)(k0 + kk) * ldn + n0 + (lane & 31)]; }
#pragma unroll
    for (int i = 0; i < 32; ++i) { const int kk = 2 * i + (lane >> 5); scr[kk * 33 + (lane & 31)] = v[i]; }
    asm volatile("s_waitcnt lgkmcnt(0)" ::: "memory");
    const int c = lane & 7;
#pragma unroll
    for (int j = 0; j < 4; ++j) { const int n = (lane >> 3) + 8 * j; const LAS float* s = scr + (8 * c) * 33 + n;
        u32x4 o; o.x = pk2(s[0 * 33], s[1 * 33]); o.y = pk2(s[2 * 33], s[3 * 33]); o.z = pk2(s[4 * 33], s[5 * 33]); o.w = pk2(s[6 * 33], s[7 * 33]);
        *(u32x4*)(WT + (size_t)(row0 + n) * ldk + k0 + 8 * c) = o; }
    asm volatile("s_waitcnt lgkmcnt(0)" ::: "memory");
}

__device__ __forceinline__ void p0_weights(Frame& F) {
    const Ids I = get_ids();
    LAS float* scr = (LAS float*)(F.lds + I.wave * 16384);
    const int gw = F.bid * 8 + I.wave, NGW = F.G * 8;
    constexpr int I_IN = 32 * 119, I_UQ = 6 * 48, I_UKV = 4 * 64, I_OUT = 32 * 64, I_F1 = 32 * 352, I_F2 = 88 * 64, I_L = I_IN + I_UQ + I_UKV + I_OUT + I_F1 + I_F2;
    for (int it = gw; it < 2 * I_L; it += NGW) {
        const int l = it / I_L; int r = it % I_L;
        if (r < I_IN) {
            const int kb = r / 119, nb = r % 119, n0 = nb * 32; const float* W = F.in[I_WIN] + (size_t)l * DM * 3808;
            bf16_t* WT = WSP(bf16_t, WS_WINT) + (size_t)l * NT_ * DM; bf16_t* WN = WSP(bf16_t, WS_WINN) + (size_t)l * NN_ * DM;
            if (n0 < 1536) transpose_item(W, 3808, kb * 64, n0, WT, DM, n0, scr, I.lane);
            else if (n0 < 1792) transpose_item(W, 3808, kb * 64, n0, WN, DM, UN_Q + (n0 - 1536), scr, I.lane);
            else if (n0 < 2048) { transpose_item(W, 3808, kb * 64, n0, WT, DM, UT_GK + (n0 - 1792), scr, I.lane); transpose_item(W, 3808, kb * 64, n0, WN, DM, UN_K + (n0 - 1792), scr, I.lane); }
            else if (n0 < 2560) transpose_item(W, 3808, kb * 64, n0, WT, DM, UT_GV + (n0 - 2048), scr, I.lane);
            else if (n0 < 3072) transpose_item(W, 3808, kb * 64, n0, WN, DM, UN_G + (n0 - 2560), scr, I.lane);
            else if (n0 < 3104) transpose_item(W, 3808, kb * 64, n0, WN, DM, UN_AF + (n0 - 3072), scr, I.lane);
            else if (n0 < 3488) transpose_item(W, 3808, kb * 64, n0, WN, DM, UN_CQ + (n0 - 3104), scr, I.lane);
            else if (n0 < 3744) transpose_item(W, 3808, kb * 64, n0, WN, DM, UN_CKV + (n0 - 3488), scr, I.lane);
            else transpose_item(W, 3808, kb * 64, n0, WN, DM, UN_KR + (n0 - 3744), scr, I.lane);
            continue; }
        r -= I_IN;
        if (r < I_UQ) { const int kb = r / 48, nb = r % 48; transpose_item(F.in[I_WUQ] + (size_t)l * 384 * 1536, 1536, kb * 64, nb * 32, WSP(bf16_t, WS_WUQ) + (size_t)l * 1536 * 384, 384, nb * 32, scr, I.lane); continue; }
        r -= I_UQ;
        if (r < I_UKV) { const int kb = r / 64, nb = r % 64, n0 = nb * 32, h = n0 >> 8, j = n0 & 255;
            if (j < 128) transpose_item(F.in[I_WUKV] + (size_t)l * 256 * 2048, 2048, kb * 64, n0, WSP(bf16_t, WS_WUK) + (size_t)l * 1024 * 256, 256, h * 128 + j, scr, I.lane);
            else transpose_item(F.in[I_WUKV] + (size_t)l * 256 * 2048, 2048, kb * 64, n0, WSP(bf16_t, WS_WUV) + (size_t)l * 1024 * 256, 256, h * 128 + (j - 128), scr, I.lane);
            continue; }
        r -= I_UKV;
        if (r < I_OUT) { const int kb = r / 64, nb = r % 64; transpose_item(F.in[I_WOUT] + (size_t)l * DM * DM, DM, kb * 64, nb * 32, WSP(bf16_t, WS_WOUT) + (size_t)l * DM * DM, DM, nb * 32, scr, I.lane); continue; }
        r -= I_OUT;
        if (r < I_F1) { const int kb = r / 352, nb = r % 352, n0 = nb * 32; const int up = n0 >= DFF, j = up ? n0 - DFF : n0;
            transpose_item(F.in[I_WF1] + (size_t)l * DM * 2 * DFF, 2 * DFF, kb * 64, n0, WSP(bf16_t, WS_WF1) + (size_t)l * 2 * DFF * DM, DM, 256 * (j >> 7) + (up ? 128 : 0) + (j & 127), scr, I.lane); continue; }
        r -= I_F1;
        { const int kb = r / 64, nb = r % 64; transpose_item(F.in[I_WF2] + (size_t)l * DFF * DM, DM, kb * 64, nb * 32, WSP(bf16_t, WS_WF2) + (size_t)l * DM * DFF, DFF, nb * 32, scr, I.lane); }
    }
    { const int gt = F.bid * 512 + I.tid, NT = F.G * 512;
      for (int i = gt; i < 2 * 8192; i += NT) { const int l = i / 8192, e = i % 8192; *(u32x4*)(WSP(bf16_t, WS_WINN) + (size_t)l * NN_ * DM + (size_t)1760 * DM + e * 8) = (u32x4){0u, 0u, 0u, 0u}; } }
    { const int gt = F.bid * 512 + I.tid, NT = F.G * 512;
      for (int i = gt; i < 2 * 2048 * 64; i += NT) { const int l = i / (2048 * 64), e = i % (2048 * 64), rr = e >> 6, c4 = (e & 63) * 4, b = rr >> 8, j = rr & 255;
          const f32x4 v = *(const f32x4*)(F.in[I_CCKV] + ((size_t)(b * 2 + l) * 256 + j) * 256 + c4);
          *(u32x2*)(WSP(bf16_t, WS_CKVN) + ((size_t)l * MKV + MT + rr) * 256 + c4) = (u32x2){pk2(v[0], v[1]), pk2(v[2], v[3])}; }
      for (int i = gt; i < 2 * 2048 * 16; i += NT) { const int l = i / (2048 * 16), e = i % (2048 * 16), rr = e >> 4, c4 = (e & 15) * 4, b = rr >> 8, j = rr & 255;
          const f32x4 v = *(const f32x4*)(F.in[I_CKR] + ((size_t)(b * 2 + l) * 256 + j) * 64 + c4);
          *(u32x2*)(WSP(bf16_t, WS_KRB) + ((size_t)l * MKV + MT + rr) * 64 + c4) = (u32x2){pk2(v[0], v[1]), pk2(v[2], v[3])}; } }
}

__device__ __forceinline__ void p0_mod(Frame& F) {
    const Ids I = get_ids();
    LAS float* sc = (LAS float*)F.lds;
    LAS float* red = (LAS float*)(F.lds + 9 * 2048 * 4);
    for (int i = I.tid; i < 9 * 2048; i += 512) { const int r = i >> 11, k = i & 2047; const float c = r < 8 ? F.in[I_C][r * 2048 + k] : F.in[I_CCTX][k]; sc[i] = siluf(c); }
    __syncthreads();
    for (int it = F.bid; it < 2 * 384; it += F.G) {
        const int l = it / 384, n0 = (it % 384) * 32, col = n0 + (I.lane & 31), kp = I.lane >> 5;
        const float* W = F.in[I_WMOD] + (size_t)l * DM * NMOD + col;
        float acc[9];
#pragma unroll
        for (int r = 0; r < 9; ++r) acc[r] = 0.f;
        const int kbase = I.wave * 256;
#pragma unroll 8
        for (int i = 0; i < 128; ++i) { const int k = kbase + 2 * i + kp; const float w = W[(size_t)k * NMOD];
#pragma unroll
            for (int r = 0; r < 9; ++r) acc[r] += sc[r * 2048 + k] * w; }
#pragma unroll
        for (int r = 0; r < 9; ++r) { acc[r] += __shfl_xor(acc[r], 32); if (I.lane < 32) red[(I.wave * 9 + r) * 32 + I.lane] = acc[r]; }
        __syncthreads();
        if (I.tid < 288) { const int r = I.tid >> 5, c = I.tid & 31; float s = 0.f;
#pragma unroll
            for (int w = 0; w < 8; ++w) s += red[(w * 9 + r) * 32 + c];
            WSP(float, WS_MOD)[((size_t)l * 9 + r) * NMOD + n0 + c] = s + F.in[I_BMOD][(size_t)l * NMOD + n0 + c]; }
        __syncthreads();
    }
}

__device__ __forceinline__ void p0_filters(Frame& F) {
    const Ids I = get_ids();
    LAS float* scr = (LAS float*)(F.lds + 90112 + I.wave * 6144);
    LAS float* zb = scr; LAS float* h1 = scr + 8 * 33; LAS float* h2 = h1 + 8 * 64;
    const int gw = F.bid * 8 + I.wave, NGW = F.G * 8, lane = I.lane;
    for (int it = gw; it < 2 * 160; it += NGW) {
        const int l = it / 160, r = it % 160, grp = r >= 32, tb = grp ? r - 32 : r, L = grp ? 1024 : 256, t0 = tb * 8;
        const float* w1 = F.in[I_HW1] + l * 33 * 64; const float* b1 = F.in[I_HB1] + l * 64; const float* fr = F.in[I_HFREQ] + l * 128;
        const float* w2 = F.in[I_HW2] + l * 64 * 64; const float* b2 = F.in[I_HB2] + l * 64; const float* w3 = F.in[I_HW3] + (size_t)l * 64 * 2048;
        for (int e = lane; e < 8 * 33; e += 64) { const int tt = e / 33, j = e % 33, t = t0 + tt; float z;
            if (j == 0) z = (float)t / (float)(L - 1);
            else { const int band = (j - 1) & 15; const float f = 1e-4f + (float)band * ((15.f - 1e-4f) / 15.f); float turns = f * (float)t / (float)L; turns -= floorf(turns);
                   z = j <= 16 ? cos_turns(turns) : -sin_turns(turns); }
            zb[e] = z; }
        asm volatile("s_waitcnt lgkmcnt(0)" ::: "memory");
        { float a[8];
#pragma unroll
          for (int tt = 0; tt < 8; ++tt) a[tt] = b1[lane];
          for (int i = 0; i < 33; ++i) { const float w = w1[i * 64 + lane];
#pragma unroll
              for (int tt = 0; tt < 8; ++tt) a[tt] += zb[tt * 33 + i] * w; }
          const float f0 = fr[lane];
#pragma unroll
          for (int tt = 0; tt < 8; ++tt) h1[tt * 64 + lane] = sin_rad(f0 * a[tt]); }
        asm volatile("s_waitcnt lgkmcnt(0)" ::: "memory");
        { float a[8];
#pragma unroll
          for (int tt = 0; tt < 8; ++tt) a[tt] = b2[lane];
          for (int i = 0; i < 64; ++i) { const float w = w2[i * 64 + lane];
#pragma unroll
              for (int tt = 0; tt < 8; ++tt) a[tt] += h1[tt * 64 + i] * w; }
          const float f1 = fr[64 + lane];
#pragma unroll
          for (int tt = 0; tt < 8; ++tt) h2[tt * 64 + lane] = sin_rad(f1 * a[tt]); }
        asm volatile("s_waitcnt lgkmcnt(0)" ::: "memory");
        float* HF = WSP(float, WS_HF) + (size_t)l * HF_L + (grp ? (size_t)2 * 512 * 512 : 0);
        for (int q = 0; q < 32; ++q) { const int n = q * 64 + lane, side = n >> 10, o = (n >> 9) & 1, c = n & 511;
            float a[8];
#pragma unroll
            for (int tt = 0; tt < 8; ++tt) a[tt] = 0.f;
            for (int i = 0; i < 64; ++i) { const float w = w3[(size_t)i * 2048 + n];
#pragma unroll
                for (int tt = 0; tt < 8; ++tt) a[tt] += h2[tt * 64 + i] * w; }
            const float delta = 3.0701134573f + (float)c * ((15.3505672866f - 3.0701134573f) / 511.f);
            float* dst = HF + ((size_t)o * 512 + c) * (2 * L) + L;
#pragma unroll
            for (int tt = 0; tt < 8; ++tt) { const int t = t0 + tt; const float tl = (float)t / (float)(L - 1); const float v = a[tt] * __expf(-tl * delta);
                if (side == 0) dst[t] = v; else if (t > 0) dst[-t] = v; } }
        asm volatile("s_waitcnt lgkmcnt(0)" ::: "memory");
    }
}

__device__ __forceinline__ void phase_norm(Frame& F, int l, const float* x0, const float* x1, int split, const float* ln, int sc_off, int sh_off) {
    const Ids I = get_ids();
    const int gw = F.bid * 8 + I.wave, NGW = F.G * 8;
    bf16_t* XN = WSP(bf16_t, WS_XN);
    for (int m = gw; m < MT; m += NGW) {
        const float* xr = m < split ? x0 + (size_t)m * DM : x1 + (size_t)(m - split) * DM;
        const int r9 = m < MC ? 8 : ((m - MC) >> 10);
        const float* mod = WSP(float, WS_MOD) + ((size_t)l * 9 + r9) * NMOD;
        f32x4 v[8]; float ss = 0.f;
#pragma unroll
        for (int j = 0; j < 8; ++j) { v[j] = *(const f32x4*)(xr + 4 * (64 * j + I.lane)); ss += (v[j][0] * v[j][0] + v[j][1] * v[j][1]) + (v[j][2] * v[j][2] + v[j][3] * v[j][3]); }
        const float rstd = 1.f / sqrtf(wave_sum(ss) * (1.f / DM) + EPS);
#pragma unroll
        for (int j = 0; j < 8; ++j) { const int col = 4 * (64 * j + I.lane);
            const f32x4 g = *(const f32x4*)(ln + col), sc = *(const f32x4*)(mod + sc_off + col), sh = *(const f32x4*)(mod + sh_off + col);
            const f32x4 y = v[j] * rstd * g * (sc + 1.f) + sh;
            *(u32x2*)(XN + (size_t)m * DM + col) = (u32x2){pk2(y[0], y[1]), pk2(y[2], y[3])}; }
    }
}
__device__ __forceinline__ void phase_final(Frame& F, const float* x, const float* ln) {
    const Ids I = get_ids();
    const int gw = F.bid * 8 + I.wave, NGW = F.G * 8;
    for (int m = gw; m < MT; m += NGW) {
        const float* xr = x + (size_t)m * DM;
        f32x4 v[8]; float ss = 0.f;
#pragma unroll
        for (int j = 0; j < 8; ++j) { v[j] = *(const f32x4*)(xr + 4 * (64 * j + I.lane)); ss += (v[j][0] * v[j][0] + v[j][1] * v[j][1]) + (v[j][2] * v[j][2] + v[j][3] * v[j][3]); }
        const float rstd = 1.f / sqrtf(wave_sum(ss) * (1.f / DM) + EPS);
#pragma unroll
        for (int j = 0; j < 8; ++j) { const int col = 4 * (64 * j + I.lane); const f32x4 g = *(const f32x4*)(ln + col);
            *(f32x4*)(F.out + O_Y + (size_t)m * DM + col) = v[j] * rstd * g; }
    }
}

__device__ __forceinline__ void phase_prep(Frame& F, int l) {
    const Ids I = get_ids();
    const int gw = F.bid * 8 + I.wave, NGW = F.G * 8, lane = I.lane;
    const bf16_t* UN = WSP(bf16_t, WS_UN);
    const float* qn = F.in[I_QNORM] + l * 384; const float* kvn = F.in[I_KVNORM] + l * 256;
    for (int m = gw; m < MT; m += NGW) {
        const bf16_t* ur = UN + (size_t)m * NN_;
        { const unsigned* p = (const unsigned*)(ur + UN_CQ + 6 * lane); const unsigned w0 = p[0], w1 = p[1], w2 = p[2];
          float v[6] = {lo16(w0), hi16(w0), lo16(w1), hi16(w1), lo16(w2), hi16(w2)}; float ss = 0.f;
#pragma unroll
          for (int i = 0; i < 6; ++i) ss += v[i] * v[i];
          const float rstd = 1.f / sqrtf(wave_sum(ss) * (1.f / 384.f) + EPS);
          unsigned* o = (unsigned*)(WSP(bf16_t, WS_CQN) + (size_t)m * 384 + 6 * lane);
#pragma unroll
          for (int i = 0; i < 3; ++i) o[i] = pk2(v[2 * i] * rstd * qn[6 * lane + 2 * i], v[2 * i + 1] * rstd * qn[6 * lane + 2 * i + 1]); }
        { const u32x2 w = *(const u32x2*)(ur + UN_CKV + 4 * lane); float v[4] = {lo16(w.x), hi16(w.x), lo16(w.y), hi16(w.y)};
          const float ss = v[0] * v[0] + v[1] * v[1] + v[2] * v[2] + v[3] * v[3];
          const float rstd = 1.f / sqrtf(wave_sum(ss) * (1.f / 256.f) + EPS);
          const f32x4 g = *(const f32x4*)(kvn + 4 * lane); const f32x4 y = {v[0] * rstd * g[0], v[1] * rstd * g[1], v[2] * rstd * g[2], v[3] * rstd * g[3]};
          *(u32x2*)(WSP(bf16_t, WS_CKVN) + ((size_t)l * MKV + m) * 256 + 4 * lane) = (u32x2){pk2(y[0], y[1]), pk2(y[2], y[3])};
          if (m < MC) { const int b = m >> 8, t = m & 255; *(f32x4*)(F.out + O_CKV + ((size_t)(b * 2 + l) * 256 + t) * 256 + 4 * lane) = y; } }
        { const float v = bf2f(ur[UN_KR + lane]); float o = v;
          if (m < MC) { const int b = m >> 8, t = m & 255; F.out[O_KR + ((size_t)(b * 2 + l) * 256 + t) * 64 + lane] = v; }
          else { const int t = (m - MC) & 1023; const int pos = lane < 32 ? (t >> 6) : (t & 63); const int i = lane & 15;
                 const float inv = __builtin_amdgcn_exp2f(-(float)i * (13.287712379549449f / 16.f));
                 float turns = (float)pos * inv * 0.15915494309189535f; turns -= floorf(turns);
                 const float cs = cos_turns(turns), sn = sin_turns(turns); const float pv = __shfl_xor(v, 16);
                 o = (lane & 16) ? (pv * sn + v * cs) : (v * cs - pv * sn); }
          WSP(bf16_t, WS_KRB)[((size_t)l * MKV + m) * 64 + lane] = (bf16_t)f2bf(o); }
    }
}

constexpr int KSTR = 400, VSTR = 136;
constexpr int KTILE = 64 * KSTR, VTILE = 128 * VSTR, ABUF = KTILE + VTILE;
__device__ __forceinline__ void attn_unit(Frame& F, int l, int grp, int b, int h, int qb) {
    const Ids I = get_ids();
    const int tid = I.tid, lane = I.lane, wave = I.wave, r32 = lane & 31, hi = lane >> 5;
    const bf16_t* Q = WSP(bf16_t, WS_Q); const bf16_t* KN = WSP(bf16_t, WS_KN); const bf16_t* VT = WSP(bf16_t, WS_VT); const bf16_t* KR = WSP(bf16_t, WS_KRB) + (size_t)l * MKV * 64;
    const int qrow0 = grp ? MC + b * 1024 + qb * 256 : b * 256;
    const int ntile = grp ? 20 : 4;
    const int qrow = qrow0 + wave * 32 + r32;
    bf16x8 qr[12];
#pragma unroll
    for (int s = 0; s < 12; ++s) qr[s] = *(const bf16x8*)(Q + (size_t)qrow * 1536 + h * 192 + 16 * s + 8 * hi);
    if (grp) {
        const int t = (qrow - MC) & 1023;
#pragma unroll
        for (int half = 0; half < 2; ++half) { const int pos = half ? (t & 63) : (t >> 6);
#pragma unroll
            for (int j = 0; j < 8; ++j) { const int i = 8 * hi + j; const float inv = __builtin_amdgcn_exp2f(-(float)i * (13.287712379549449f / 16.f));
                float turns = (float)pos * inv * 0.15915494309189535f; turns -= floorf(turns); const float cs = cos_turns(turns), sn = sin_turns(turns);
                const float x1 = bf2f((bf16_t)qr[8 + 2 * half][j]), x2 = bf2f((bf16_t)qr[9 + 2 * half][j]);
                qr[8 + 2 * half][j] = (short)f2bf(x1 * cs - x2 * sn); qr[9 + 2 * half][j] = (short)f2bf(x1 * sn + x2 * cs); } }
    }
    f32x16 o[4];
#pragma unroll
    for (int d = 0; d < 4; ++d) o[d] = (f32x16){};
    float m_run = -1e30f, l_run = 0.f;
    constexpr float C = 0.07216878364870322f * 1.4426950408889634f;
    u32x4 sk0, sk1, skr, sv0, sv1;
    auto key_base = [&](int tb) -> int { return grp ? (tb < 16 ? MC + b * 1024 + tb * 64 : MT + b * 256 + (tb - 16) * 64) : b * 256 + tb * 64; };
    auto gload = [&](int tb) { const int kb = key_base(tb);
        { const int e = tid, row = e >> 4, ch = e & 15; sk0 = *(const u32x4*)(KN + (size_t)(kb + row) * 1024 + h * 128 + ch * 8); }
        { const int e = tid + 512, row = e >> 4, ch = e & 15; sk1 = *(const u32x4*)(KN + (size_t)(kb + row) * 1024 + h * 128 + ch * 8); }
        { const int row = tid >> 3, ch = tid & 7; skr = *(const u32x4*)(KR + (size_t)(kb + row) * 64 + ch * 8); }
        { const int e = tid, row = e >> 3, ch = e & 7; sv0 = *(const u32x4*)(VT + (size_t)(h * 128 + row) * MKV + kb + ch * 8); }
        { const int e = tid + 512, row = e >> 3, ch = e & 7; sv1 = *(const u32x4*)(VT + (size_t)(h * 128 + row) * MKV + kb + ch * 8); } };
    auto lstore = [&](int buf) { LAS unsigned char* kb = F.lds + buf * ABUF; LAS unsigned char* vb = kb + KTILE;
        { const int e = tid, row = e >> 4, ch = e & 15; *(LAS u32x4*)(kb + row * KSTR + ch * 16) = sk0; }
        { const int e = tid + 512, row = e >> 4, ch = e & 15; *(LAS u32x4*)(kb + row * KSTR + ch * 16) = sk1; }
        { const int row = tid >> 3, ch = tid & 7; *(LAS u32x4*)(kb + row * KSTR + 256 + ch * 16) = skr; }
        { const int e = tid, row = e >> 3, ch = e & 7; *(LAS u32x2*)(vb + row * VSTR + ch * 16) = (u32x2){sv0.x, sv0.y}; *(LAS u32x2*)(vb + row * VSTR + ch * 16 + 8) = (u32x2){sv0.z, sv0.w}; }
        { const int e = tid + 512, row = e >> 3, ch = e & 7; *(LAS u32x2*)(vb + row * VSTR + ch * 16) = (u32x2){sv1.x, sv1.y}; *(LAS u32x2*)(vb + row * VSTR + ch * 16 + 8) = (u32x2){sv1.z, sv1.w}; } };
    __syncthreads();
    gload(0); lstore(0); __syncthreads();
    for (int tb = 0; tb < ntile; ++tb) {
        const int buf = tb & 1;
        if (tb + 1 < ntile) gload(tb + 1);
        LAS unsigned char* kb = F.lds + buf * ABUF; LAS unsigned char* vb = kb + KTILE;
        f32x16 p0 = (f32x16){}, p1 = (f32x16){};
#pragma unroll
        for (int s = 0; s < 12; ++s) {
            const bf16x8 k0 = *(const LAS bf16x8*)(kb + r32 * KSTR + (16 * s + 8 * hi) * 2);
            const bf16x8 k1 = *(const LAS bf16x8*)(kb + (32 + r32) * KSTR + (16 * s + 8 * hi) * 2);
            p0 = __builtin_amdgcn_mfma_f32_32x32x16_bf16(k0, qr[s], p0, 0, 0, 0);
            p1 = __builtin_amdgcn_mfma_f32_32x32x16_bf16(k1, qr[s], p1, 0, 0, 0);
        }
        float pmax = p0[0];
#pragma unroll
        for (int r = 1; r < 16; ++r) pmax = fmaxf(pmax, p0[r]);
#pragma unroll
        for (int r = 0; r < 16; ++r) pmax = fmaxf(pmax, p1[r]);
        pmax = fmaxf(pmax, __shfl_xor(pmax, 32));
        const float mn = fmaxf(m_run, pmax); const float alpha = __builtin_amdgcn_exp2f((m_run - mn) * C); m_run = mn;
        const float mnC = -mn * C; float ps = 0.f;
#pragma unroll
        for (int r = 0; r < 16; ++r) { p0[r] = __builtin_amdgcn_exp2f(fmaf(p0[r], C, mnC)); p1[r] = __builtin_amdgcn_exp2f(fmaf(p1[r], C, mnC)); ps += p0[r] + p1[r]; }
        l_run = l_run * alpha + ps;
#pragma unroll
        for (int d = 0; d < 4; ++d)
#pragma unroll
            for (int r = 0; r < 16; ++r) o[d][r] *= alpha;
        bf16x8 pb[4];
#pragma unroll
        for (int ks = 0; ks < 4; ++ks) { u32x4 w;
#pragma unroll
            for (int jj = 0; jj < 4; ++jj) { const int r = (ks & 1) * 8 + 2 * jj; const float a = ks < 2 ? p0[r] : p1[r], bq = ks < 2 ? p0[r + 1] : p1[r + 1]; w[jj] = pg8::cvt_pk_bf16(a, bq); }
            pb[ks] = __builtin_bit_cast(bf16x8, w); }
#pragma unroll
        for (int d = 0; d < 4; ++d)
#pragma unroll
            for (int ks = 0; ks < 4; ++ks) { const LAS unsigned char* vp = vb + (32 * d + r32) * VSTR + (16 * ks + 4 * hi) * 2;
                const s16x4 lo = *(const LAS s16x4*)vp, hh = *(const LAS s16x4*)(vp + 16);
                const bf16x8 va = (bf16x8){lo[0], lo[1], lo[2], lo[3], hh[0], hh[1], hh[2], hh[3]};
                o[d] = __builtin_amdgcn_mfma_f32_32x32x16_bf16(va, pb[ks], o[d], 0, 0, 0); }
        if (tb + 1 < ntile) lstore(buf ^ 1);
        __syncthreads();
    }
    const float lt = l_run + __shfl_xor(l_run, 32); const float rl = 1.f / lt;
    bf16_t* yo = WSP(bf16_t, WS_YMIX) + (size_t)qrow * DM + 1024 + h * 128;
#pragma unroll
    for (int d = 0; d < 4; ++d)
#pragma unroll
        for (int g4 = 0; g4 < 4; ++g4) { const int dv = 32 * d + 8 * g4 + 4 * hi;
            *(u32x2*)(yo + dv) = (u32x2){pk2(o[d][4 * g4] * rl, o[d][4 * g4 + 1] * rl), pk2(o[d][4 * g4 + 2] * rl, o[d][4 * g4 + 3] * rl)}; }
}
__device__ __forceinline__ void phase_attn(Frame& F, int l) {
    for (int u = F.bid; u < 384; u += F.G) {
        if (u < 256) attn_unit(F, l, 1, u >> 5, (u >> 2) & 7, u & 3);
        else { const int v = u - 256; attn_unit(F, l, 0, v >> 3, v & 7, 0); }
    }
    __syncthreads();
}

__device__ __forceinline__ void gla_unit(Frame& F, int l, int grp, int b, int h, int dir, int dvq) {
    const Ids I = get_ids();
    const int tid = I.tid, dvl = tid >> 4, dkg = tid & 15, dv = 32 * dvq + dvl;
    const int L = grp ? 1024 : 256, row0 = grp ? MC + b * 1024 : b * 256;
    const bf16_t* UN = WSP(bf16_t, WS_UN); const bf16_t* UT = WSP(bf16_t, WS_UT);
    const float* wa = (dir ? F.in[I_WAB] : F.in[I_WAF]) + l * 16 * 256 + h * 64; const float* ba = (dir ? F.in[I_BAB] : F.in[I_BAF]) + l * 256 + h * 64;
    const int afo = dir ? UN_AB : UN_AF;
    float* Oo = WSP(float, dir ? WS_OB : WS_OF);
    LAS float* sq = (LAS float*)F.lds; LAS float* sk = sq + 4096; LAS float* sa = sk + 4096; LAS float* sv = sa + 4096;
    float S[4];
    if (grp) { const float* st = (dir ? F.in[I_SGB] : F.in[I_SGF]) + ((size_t)((b * 2 + l) * 4 + h) * 64 + 4 * dkg) * 128 + dv;
#pragma unroll
        for (int c = 0; c < 4; ++c) S[c] = st[c * 128]; }
    else { S[0] = S[1] = S[2] = S[3] = 0.f; }
    for (int ci = 0; ci < L / 64; ++ci) {
        __syncthreads();
        for (int e = tid; e < 4096; e += 512) { const int i = e >> 6, d = e & 63; const int t = dir ? L - 1 - (64 * ci + i) : 64 * ci + i; const bf16_t* ur = UN + (size_t)(row0 + t) * NN_;
            sq[e] = bf2f(ur[UN_Q + h * 64 + d]) * 0.125f; sk[e] = bf2f(ur[UN_K + h * 64 + d]);
            float x = ba[d];
#pragma unroll
            for (int r = 0; r < 16; ++r) x += bf2f(ur[afo + r]) * wa[r * 256 + d];
            const float ls = fminf(x, 0.f) - __logf(1.f + __expf(-fabsf(x)));
            sa[e] = __expf(ls * (1.f / 16.f)); }
        for (int e = tid; e < 2048; e += 512) { const int j = e >> 6, i = e & 63; const int t = dir ? L - 1 - (64 * ci + i) : 64 * ci + i;
            sv[i * 33 + j] = bf2f(UT[(size_t)(UT_GV + h * 128 + 32 * dvq + j) * MT + row0 + t]); }
        __syncthreads();
        for (int i = 0; i < 64; ++i) {
            const f32x4 a4 = *(const LAS f32x4*)(sa + i * 64 + 4 * dkg), k4 = *(const LAS f32x4*)(sk + i * 64 + 4 * dkg), q4 = *(const LAS f32x4*)(sq + i * 64 + 4 * dkg);
            const float vv = sv[i * 33 + dvl]; float oo = 0.f;
#pragma unroll
            for (int c = 0; c < 4; ++c) { S[c] = a4[c] * S[c] + k4[c] * vv; oo += q4[c] * S[c]; }
            oo += __shfl_xor(oo, 1); oo += __shfl_xor(oo, 2); oo += __shfl_xor(oo, 4); oo += __shfl_xor(oo, 8);
            const int t = dir ? L - 1 - (64 * ci + i) : 64 * ci + i;
            if (dkg == 0) Oo[(size_t)(row0 + t) * 512 + h * 128 + dv] = oo;
        }
    }
    if (!grp) { float* so = F.out + (dir ? O_GB : O_GF) + ((size_t)((b * 2 + l) * 4 + h) * 64 + 4 * dkg) * 128 + dv;
#pragma unroll
        for (int c = 0; c < 4; ++c) so[c * 128] = S[c]; }
}
__device__ __forceinline__ void phase_gla(Frame& F, int l) {
    for (int u = F.bid; u < 768; u += F.G) {
        if (u < 256) gla_unit(F, l, 1, u >> 5, (u >> 3) & 3, (u >> 2) & 1, u & 3);
        else { const int v = u - 256; gla_unit(F, l, 0, v >> 5, (v >> 3) & 3, (v >> 2) & 1, v & 3); }
    }
    __syncthreads();
}
__device__ __forceinline__ void phase_gla_combine(Frame& F, int l) {
    const Ids I = get_ids();
    const int gw = F.bid * 8 + I.wave, NGW = F.G * 8, lane = I.lane;
    const float* gn = F.in[I_GNORM] + l * 128;
    for (int m = gw; m < MT; m += NGW) {
        const float* pf = WSP(float, WS_OF) + (size_t)m * 512 + 8 * lane; const float* pb = WSP(float, WS_OB) + (size_t)m * 512 + 8 * lane;
        const f32x4 a0 = *(const f32x4*)pf, a1 = *(const f32x4*)(pf + 4), b0 = *(const f32x4*)pb, b1 = *(const f32x4*)(pb + 4);
        float o[8] = {a0[0] + b0[0], a0[1] + b0[1], a0[2] + b0[2], a0[3] + b0[3], a1[0] + b1[0], a1[1] + b1[1], a1[2] + b1[2], a1[3] + b1[3]};
        float ss = 0.f;
#pragma unroll
        for (int i = 0; i < 8; ++i) ss += o[i] * o[i];
        ss += __shfl_xor(ss, 1); ss += __shfl_xor(ss, 2); ss += __shfl_xor(ss, 4); ss += __shfl_xor(ss, 8);
        const float rstd = 1.f / sqrtf(ss * (1.f / 128.f) + EPS);
        const u32x4 gw4 = *(const u32x4*)(WSP(bf16_t, WS_UN) + (size_t)m * NN_ + UN_G + 8 * lane);
        const float gg[8] = {lo16(gw4.x), hi16(gw4.x), lo16(gw4.y), hi16(gw4.y), lo16(gw4.z), hi16(gw4.z), lo16(gw4.w), hi16(gw4.w)};
        const int dv0 = (8 * lane) & 127; float y[8];
#pragma unroll
        for (int i = 0; i < 8; ++i) y[i] = o[i] * rstd * gn[dv0 + i] * siluf(gg[i]);
        *(u32x4*)(WSP(bf16_t, WS_YMIX) + (size_t)m * DM + 512 + 8 * lane) = (u32x4){pk2(y[0], y[1]), pk2(y[2], y[3]), pk2(y[4], y[5]), pk2(y[6], y[7])};
    }
}

__device__ __forceinline__ void hyena_unit(Frame& F, int l, int grp, int c) {
    const Ids I = get_ids();
    const int tid = I.tid;
    const int L = grp ? 1024 : 256, NB = grp ? 8 : 16;
    const bf16_t* UT = WSP(bf16_t, WS_UT);
    const float* cw = F.in[I_HCW] + (size_t)l * 3 * 1536; const float* cb = F.in[I_HCB] + (size_t)l * 1536;
    LAS float* zb = (LAS float*)F.lds;
    LAS float* hb = zb + 8192;
    const float* HF = WSP(float, WS_HF) + (size_t)l * HF_L + (grp ? (size_t)2 * 512 * 512 : 0);
    auto sconv = [&](int cc, int bb, int t) -> float { const bf16_t* ur = UT + (size_t)cc * MT + (grp ? MC + bb * 1024 : bb * 256);
        const float um = t > 0 ? bf2f(ur[t - 1]) : 0.f, u0 = bf2f(ur[t]), up = t < L - 1 ? bf2f(ur[t + 1]) : 0.f;
        return cw[cc] * um + cw[1536 + cc] * u0 + cw[3072 + cc] * up + cb[cc]; };
    __syncthreads();
    for (int e = tid; e < L * NB; e += 512) { const int bb = e / L, t = e % L; zb[t * NB + bb] = sconv(c, bb, t); }
    for (int e = tid; e < 2 * L; e += 512) hb[e] = HF[((size_t)0 * 512 + c) * (2 * L) + e];
    __syncthreads();
    const int tA = grp ? tid : (tid & 255), bg = grp ? 0 : (tid >> 8) * 8;
    for (int o = 0; o < 2; ++o) {
        float acc0[8], acc1[8];
#pragma unroll
        for (int q = 0; q < 8; ++q) { acc0[q] = 0.f; acc1[q] = 0.f; }
        for (int s = 0; s < L; ++s) {
            const f32x4 z0 = *(const LAS f32x4*)(zb + s * NB + bg), z1 = *(const LAS f32x4*)(zb + s * NB + bg + 4);
            const float h0 = hb[L + tA - s];
#pragma unroll
            for (int q = 0; q < 4; ++q) { acc0[q] += h0 * z0[q]; acc0[4 + q] += h0 * z1[q]; }
            if (grp) { const float h1 = hb[L + tA + 512 - s];
#pragma unroll
                for (int q = 0; q < 4; ++q) { acc1[q] += h1 * z0[q]; acc1[4 + q] += h1 * z1[q]; } }
        }
        const float skip = F.in[I_HSKIP][(size_t)l * 1024 + o * 512 + c];
        const int gch = 512 * (o + 1) + c;
        float r0[8], r1[8];
#pragma unroll
        for (int q = 0; q < 8; ++q) { r0[q] = sconv(gch, bg + q, tA) * (acc0[q] + zb[tA * NB + bg + q] * skip);
            r1[q] = grp ? sconv(gch, bg + q, tA + 512) * (acc1[q] + zb[(tA + 512) * NB + bg + q] * skip) : 0.f; }
        __syncthreads();
        if (o == 0) {
#pragma unroll
            for (int q = 0; q < 8; ++q) { zb[tA * NB + bg + q] = r0[q]; if (grp) zb[(tA + 512) * NB + bg + q] = r1[q]; }
            for (int e = tid; e < 2 * L; e += 512) hb[e] = HF[((size_t)1 * 512 + c) * (2 * L) + e];
            __syncthreads();
        } else {
            bf16_t* Y = WSP(bf16_t, WS_YMIX);
#pragma unroll
            for (int q = 0; q < 8; ++q) { const int bb = bg + q; const int row = grp ? MC + bb * 1024 : bb * 256;
                Y[(size_t)(row + tA) * DM + c] = (bf16_t)f2bf(r0[q]); if (grp) Y[(size_t)(row + tA + 512) * DM + c] = (bf16_t)f2bf(r1[q]); }
        }
    }
}
__device__ __forceinline__ void phase_hyena(Frame& F, int l) {
    for (int u = F.bid; u < 1024; u += F.G) hyena_unit(F, l, u < 512 ? 1 : 0, u & 511);
    __syncthreads();
}

__global__ void __launch_bounds__(512, 2) fwd_kernel(Args args) {
    extern __shared__ __attribute__((aligned(16))) unsigned char lds_raw[];
    cg::grid_group grid = cg::this_grid();
    Frame F;
    F.lds = (LAS unsigned char*)lds_raw;
    F.G = gridDim.x; F.bid = blockIdx.x; F.in = args.in; F.out = args.out; F.ws = args.ws;

    p0_mod(F);
    p0_filters(F);
    __syncthreads();
    p0_weights(F);
    grid.sync();

    for (int l = 0; l < 2; ++l) {
        const float* xa = l == 0 ? F.in[I_XP] : WSP(float, WS_X2); const float* xb = l == 0 ? F.in[I_XS] : WSP(float, WS_X2); const int split = l == 0 ? MC : MT;
        const float* modl = WSP(float, WS_MOD) + (size_t)l * 9 * NMOD;
        phase_norm(F, l, xa, xb, split, F.in[I_LNMIX] + l * DM, 1 * DM, 0 * DM);
        grid.sync();
        { pg8::Gemms g; g.K = DM; g.A0 = WSP(bf16_t, WS_WINT) + (size_t)l * NT_ * DM; g.B0 = WSP(bf16_t, WS_XN); g.A1 = WSP(bf16_t, WS_XN); g.B1 = WSP(bf16_t, WS_WINN) + (size_t)l * NN_ * DM;
          pg8::MultiOrder S; S.init(F.G, F.bid, NT_, MT, MT, NN_);
          pg8::EpiStore E; E.O0 = WSP(bf16_t, WS_UT); E.ld0 = MT; E.O1 = WSP(bf16_t, WS_UN); E.ld1 = NN_;
          pg8::gemm_phase(F.lds, g, S, E); }
        grid.sync();
        phase_prep(F, l);
        grid.sync();
        { pg8::Gemms g; g.K = 384; g.A0 = WSP(bf16_t, WS_CQN); g.B0 = WSP(bf16_t, WS_WUQ) + (size_t)l * 1536 * 384; g.A1 = g.A0; g.B1 = g.B0;
          pg8::MultiOrder S; S.init(F.G, F.bid, MT, 1536, 0, 0);
          pg8::EpiStore E; E.O0 = E.O1 = WSP(bf16_t, WS_Q); E.ld0 = E.ld1 = 1536;
          pg8::gemm_phase(F.lds, g, S, E); }
        { pg8::Gemms g; g.K = 256; const bf16_t* ck = WSP(bf16_t, WS_CKVN) + (size_t)l * MKV * 256;
          g.A0 = ck; g.B0 = WSP(bf16_t, WS_WUK) + (size_t)l * 1024 * 256; g.A1 = WSP(bf16_t, WS_WUV) + (size_t)l * 1024 * 256; g.B1 = ck;
          pg8::MultiOrder S; S.init(F.G, F.bid, MKV, 1024, 1024, MKV);
          pg8::EpiStore E; E.O0 = WSP(bf16_t, WS_KN); E.ld0 = 1024; E.O1 = WSP(bf16_t, WS_VT); E.ld1 = MKV;
          pg8::gemm_phase(F.lds, g, S, E); }
        grid.sync();
        phase_attn(F, l);
        phase_gla(F, l);
        phase_hyena(F, l);
        grid.sync();
        phase_gla_combine(F, l);
        grid.sync();
        { pg8::Gemms g; g.K = DM; g.A0 = WSP(bf16_t, WS_YMIX); g.B0 = WSP(bf16_t, WS_WOUT) + (size_t)l * DM * DM; g.A1 = g.A0; g.B1 = g.B0;
          pg8::MultiOrder S; S.init(F.G, F.bid, MT, DM, 0, 0);
          pg8::EpiResGate E; E.base0 = xa; E.base1 = xb; E.split = split; E.out = WSP(float, WS_X1); E.mod = modl; E.goff = 2 * DM;
          pg8::gemm_phase(F.lds, g, S, E); }
        grid.sync();
        phase_norm(F, l, WSP(float, WS_X1), WSP(float, WS_X1), MT, F.in[I_LNFFN] + l * DM, 4 * DM, 3 * DM);
        grid.sync();
        { pg8::Gemms g; g.K = DM; g.A0 = WSP(bf16_t, WS_XN); g.B0 = WSP(bf16_t, WS_WF1) + (size_t)l * 2 * DFF * DM; g.A1 = g.A0; g.B1 = g.B0;
          pg8::MultiOrder S; S.init(F.G, F.bid, MT, 2 * DFF, 0, 0);
          pg8::EpiSwiGLU E; E.O = WSP(bf16_t, WS_H);
          pg8::gemm_phase(F.lds, g, S, E); }
        grid.sync();
        { pg8::Gemms g; g.K = DFF; g.A0 = WSP(bf16_t, WS_H); g.B0 = WSP(bf16_t, WS_WF2) + (size_t)l * DM * DFF; g.A1 = g.A0; g.B1 = g.B0;
          pg8::MultiOrder S; S.init(F.G, F.bid, MT, DM, 0, 0);
          pg8::EpiResGate E; E.base0 = WSP(float, WS_X1); E.base1 = E.base0; E.split = MT; E.out = WSP(float, WS_X2); E.mod = modl; E.goff = 5 * DM;
          pg8::gemm_phase(F.lds, g, S, E); }
        grid.sync();
    }
    phase_final(F, WSP(float, WS_X2), F.in[I_LNFIN]);
}

extern "C" void kernel_launch(void* const* d_in, const int* in_sizes, int n_in, void* d_out, int out_size, void* d_ws, size_t ws_size, hipStream_t stream) {
    static int grid = 0;
    if (grid == 0) {
        int dev = 0, cus = 0, per_cu = 0;
        if (n_in != 35 || ws_size < WS_END) { fprintf(stderr, "kernel_launch: unexpected n_in %d / ws %zu (need %zu)\n", n_in, ws_size, (size_t)WS_END); grid = -1; return; }
        (void)hipGetDevice(&dev);
        (void)hipDeviceGetAttribute(&cus, hipDeviceAttributeMultiprocessorCount, dev);
        (void)hipFuncSetAttribute((const void*)fwd_kernel, hipFuncAttributeMaxDynamicSharedMemorySize, LDS_BYTES);
        (void)hipOccupancyMaxActiveBlocksPerMultiprocessor(&per_cu, (const void*)fwd_kernel, 512, LDS_BYTES);
        if (per_cu < 1) { fprintf(stderr, "kernel_launch: occupancy query says %d blocks/CU\n", per_cu); per_cu = 1; }
        grid = cus;
    }
    if (grid < 0) return;
    Args a{};
    for (int i = 0; i < 35; ++i) a.in[i] = (const float*)d_in[i];
    a.out = (float*)d_out; a.ws = (unsigned char*)d_ws;
    void* kargs[] = {&a};
    hipError_t e = hipLaunchCooperativeKernel((const void*)fwd_kernel, dim3(grid), dim3(512), kargs, LDS_BYTES, stream);
    if (e != hipSuccess) fprintf(stderr, "cooperative launch failed: %s (grid %d)\n", hipGetErrorString(e), grid);
}
```

```cpp
#include <hip/hip_runtime.h>
#include <hip/hip_cooperative_groups.h>
#include <cstdio>
#include <cstdint>
namespace cg = cooperative_groups;
#ifndef REP_ATTN
#define REP_ATTN 1
#endif
#ifndef REP_GLA
#define REP_GLA 1
#endif
#ifndef REP_HY
#define REP_HY 1
#endif
#ifndef REP_P0
#define REP_P0 1
#endif

#define LAS __attribute__((address_space(3)))
typedef unsigned short bf16_t;
typedef short bf16x8 __attribute__((ext_vector_type(8)));
typedef short s16x4 __attribute__((ext_vector_type(4)));
typedef float f32x4 __attribute__((ext_vector_type(4)));
typedef float f32x2 __attribute__((ext_vector_type(2)));
typedef float f32x16 __attribute__((ext_vector_type(16)));
typedef unsigned u32x4 __attribute__((ext_vector_type(4)));
typedef unsigned u32x2 __attribute__((ext_vector_type(2)));

constexpr int DM = 2048, MC = 4096, ML = 8192, MT = MC + ML;
constexpr int NMOD = 6 * DM;
constexpr int DFF = 5632;
constexpr int NT_ = 2304, NN_ = 1792;
constexpr int MKV = MT + 2048;
constexpr float EPS = 1e-6f;
constexpr int UN_Q = 0, UN_K = 256, UN_G = 512, UN_CQ = 1024, UN_CKV = 1408, UN_KR = 1664, UN_AF = 1728, UN_AB = 1744;
constexpr int UT_HY = 0, UT_GK = 1536, UT_GV = 1792;
constexpr size_t O_Y = 0, O_CKV = (size_t)MT * DM, O_KR = O_CKV + 2097152, O_GF = O_KR + 524288, O_GB = O_GF + 1048576;

constexpr size_t al(size_t x) { return (x + 255) & ~(size_t)255; }
constexpr size_t WS_MOD = 0;
constexpr size_t WS_WINT = al(WS_MOD + 2 * 9 * NMOD * 4);
constexpr size_t WS_WINN = al(WS_WINT + (size_t)2 * NT_ * DM * 2);
constexpr size_t WS_WUQ = al(WS_WINN + (size_t)2 * NN_ * DM * 2);
constexpr size_t WS_WUK = al(WS_WUQ + (size_t)2 * 1536 * 384 * 2);
constexpr size_t WS_WUV = al(WS_WUK + (size_t)2 * 1024 * 256 * 2);
constexpr size_t WS_WOUT = al(WS_WUV + (size_t)2 * 1024 * 256 * 2);
constexpr size_t WS_WF1 = al(WS_WOUT + (size_t)2 * DM * DM * 2);
constexpr size_t WS_WF2 = al(WS_WF1 + (size_t)2 * 2 * DFF * DM * 2);
constexpr size_t WS_HF = al(WS_WF2 + (size_t)2 * DM * DFF * 2);
constexpr size_t HF_L = (size_t)2 * 512 * 512 + (size_t)2 * 512 * 2048;
constexpr size_t WS_XN = al(WS_HF + 2 * HF_L * 2);
constexpr size_t WS_CKVN = al(WS_XN + (size_t)MT * DM * 2);
constexpr size_t WS_KRB = al(WS_CKVN + (size_t)2 * MKV * 256 * 2);
constexpr size_t WS_YMIX = al(WS_KRB + (size_t)2 * MKV * 64 * 2);
constexpr size_t WS_X1 = al(WS_YMIX + (size_t)MT * DM * 2);
constexpr size_t WS_X2 = al(WS_X1 + (size_t)MT * DM * 4);
constexpr size_t WS_UT = al(WS_X2 + (size_t)MT * DM * 4);
constexpr size_t WS_UN = al(WS_UT + (size_t)NT_ * MT * 2);
constexpr size_t WS_CQN = al(WS_UN + (size_t)MT * NN_ * 2);
constexpr size_t WS_Q = al(WS_CQN + (size_t)MT * 384 * 2);
constexpr size_t WS_KN = al(WS_Q + (size_t)MT * 1536 * 2);
constexpr size_t WS_VT = al(WS_KN + (size_t)MKV * 1024 * 2);
constexpr size_t WS_OF = al(WS_VT + (size_t)1024 * MKV * 2);
constexpr size_t WS_OB = al(WS_OF + (size_t)MT * 512 * 4);
constexpr size_t WS_MIXEND = al(WS_OB + (size_t)MT * 512 * 4);
constexpr size_t WS_H = WS_UT;
constexpr size_t WS_END = WS_MIXEND;
static_assert(WS_H + (size_t)MT * DFF * 2 <= WS_MIXEND, "H overlay fits");

constexpr int LDS_BYTES = 147456;

__device__ __forceinline__ float bf2f(bf16_t v) { return __uint_as_float((unsigned)v << 16); }
__device__ __forceinline__ unsigned f2bf(float f) { unsigned u = __float_as_uint(f); return (u + 0x7fffu + ((u >> 16) & 1u)) >> 16; }
__device__ __forceinline__ unsigned pk2(float lo, float hi) { return f2bf(lo) | (f2bf(hi) << 16); }
__device__ __forceinline__ float lo16(unsigned w) { return __uint_as_float(w << 16); }
__device__ __forceinline__ float hi16(unsigned w) { return __uint_as_float(w & 0xffff0000u); }
__device__ __forceinline__ float wave_sum(float v) {
#pragma unroll
    for (int o = 1; o < 64; o <<= 1) v += __shfl_xor(v, o);
    return v;
}
__device__ __forceinline__ float sin_turns(float t) { return __builtin_amdgcn_sinf(t); }
__device__ __forceinline__ float cos_turns(float t) { return __builtin_amdgcn_cosf(t); }
__device__ __forceinline__ float sin_rad(float x) { float t = x * 0.15915494309189535f; t -= floorf(t); return __builtin_amdgcn_sinf(t); }
__device__ __forceinline__ float siluf(float x) { return x / (1.f + __expf(-x)); }

namespace pg8 {
constexpr int BM = 256, BK = 64, HALF = 128, HTB = HALF * BK * 2, STAGE_BYTES = 8 * HTB, NXCD = 8, WGM = 8;
__host__ __device__ __forceinline__ int lds_byte(int r, int c) { const int st = (r >> 4) * 2 + (c >> 5), rr = r & 15, cc = c & 31, ob = rr * 64 + cc * 2; return st * 1024 + (ob ^ (((ob >> 9) & 1) << 5)); }
__host__ __device__ __forceinline__ void stage_rc(int b, int& R, int& C) { const int st = b / 1024, sb = b % 1024, swz = sb ^ (((sb >> 9) & 1) << 5); R = (st >> 1) * 16 + swz / 64; C = (st & 1) * 32 + (swz % 64) / 2; }
__host__ __device__ __forceinline__ int perm32(int rho) { const int n = rho >> 4, i = rho & 15; return 8 * (i >> 2) + 4 * n + (i & 3); }

struct Unit { int pm, pn, gi; };
struct Gemms { const bf16_t* A0; const bf16_t* B0; const bf16_t* A1; const bf16_t* B1; int K; };

struct MultiOrder {
    int nM0, nN0, nM1, nN1, n0, nwg, G, c;
    __device__ __forceinline__ void init(int G_, int c_, int M0, int N0, int M1, int N1) { G = G_; c = c_; nM0 = M0 / BM; nN0 = N0 / BM; nM1 = M1 / BM; nN1 = N1 / BM; n0 = nM0 * nN0; nwg = n0 + nM1 * nN1; }
    __device__ __forceinline__ bool next(int i, Unit& u) const {
        const long L = (long)i * G + c; if (L >= nwg) return false;
        int wgid = (int)L; { const int q = nwg / NXCD, r = nwg % NXCD, xcd = wgid % NXCD, o = wgid / NXCD; wgid = (xcd < r ? xcd * (q + 1) : r * (q + 1) + (xcd - r) * q) + o; }
        const int s = wgid >= n0 ? 1 : 0;
        const int loc = wgid - (s ? n0 : 0);
        const int nm = s ? nM1 : nM0, nn = s ? nN1 : nN0;
        const int nig = WGM * nn, gid = loc / nig, fm = gid * WGM, gsz = (nm - fm) < WGM ? (nm - fm) : WGM;
        u.pm = fm + ((loc % nig) % gsz); u.pn = (loc % nig) / gsz; u.gi = s; return true;
    }
};

__device__ __forceinline__ unsigned cvt_pk_bf16(float lo, float hi) { unsigned r; asm volatile("v_cvt_pk_bf16_f32 %0, %1, %2" : "=v"(r) : "v"(lo), "v"(hi)); return r; }

struct EpiStore {
    static constexpr bool PERM = true;
    bf16_t* O0; bf16_t* O1; int ld0, ld1;
    __device__ __forceinline__ void operator()(const f32x4 (&acc)[2][2][4][2], const Unit& u, int wr, int wc, int fr, int fq) const {
        bf16_t* base = u.gi >= 1 ? O1 : O0; const int ld = u.gi >= 1 ? ld1 : ld0;
        const int row0 = u.pm * BM + wr * 64 + fr, col0 = u.pn * BM + wc * 32 + 8 * fq;
#pragma unroll
        for (int ai = 0; ai < 2; ++ai)
#pragma unroll
            for (int m = 0; m < 4; ++m) { bf16_t* rowp = base + (size_t)(row0 + ai * HALF + m * 16) * ld + col0;
#pragma unroll
                for (int bj = 0; bj < 2; ++bj) { const f32x4 v0 = acc[ai][bj][m][0], v1 = acc[ai][bj][m][1];
                    u32x4 w; w.x = cvt_pk_bf16(v0[0], v0[1]); w.y = cvt_pk_bf16(v0[2], v0[3]); w.z = cvt_pk_bf16(v1[0], v1[1]); w.w = cvt_pk_bf16(v1[2], v1[3]);
                    *(u32x4*)(rowp + bj * HALF) = w; } }
    }
};
struct EpiSwiGLU {
    static constexpr bool PERM = true;
    bf16_t* O;
    __device__ __forceinline__ void operator()(const f32x4 (&acc)[2][2][4][2], const Unit& u, int wr, int wc, int fr, int fq) const {
        const int row0 = u.pm * BM + wr * 64 + fr, col0 = u.pn * HALF + wc * 32 + 8 * fq;
#pragma unroll
        for (int ai = 0; ai < 2; ++ai)
#pragma unroll
            for (int m = 0; m < 4; ++m) { bf16_t* rowp = O + (size_t)(row0 + ai * HALF + m * 16) * DFF + col0;
                float h[8];
#pragma unroll
                for (int n = 0; n < 2; ++n)
#pragma unroll
                    for (int e = 0; e < 4; ++e) { const float g = acc[ai][0][m][n][e], up = acc[ai][1][m][n][e]; h[n * 4 + e] = g * __builtin_amdgcn_rcpf(1.f + __expf(-g)) * up; }
                u32x4 w; w.x = cvt_pk_bf16(h[0], h[1]); w.y = cvt_pk_bf16(h[2], h[3]); w.z = cvt_pk_bf16(h[4], h[5]); w.w = cvt_pk_bf16(h[6], h[7]);
                *(u32x4*)rowp = w; }
    }
};
struct EpiResGate {
    static constexpr bool PERM = false;
    const float* base0; const float* base1; int split; float* out; const float* mod; int goff;
    __device__ __forceinline__ void operator()(const f32x4 (&acc)[2][2][4][2], const Unit& u, int wr, int wc, int fr, int fq) const {
        const int r9 = u.pm < 16 ? 8 : ((u.pm - 16) >> 2);
        const float* gate = mod + (size_t)r9 * NMOD + goff;
        const int row0 = u.pm * BM + wr * 64 + fr, col0 = u.pn * BM + wc * 32 + 4 * fq;
        f32x4 gv[2][2];
#pragma unroll
        for (int bj = 0; bj < 2; ++bj)
#pragma unroll
            for (int n = 0; n < 2; ++n) gv[bj][n] = *(const f32x4*)(gate + col0 + bj * HALF + n * 16);
#pragma unroll
        for (int ai = 0; ai < 2; ++ai)
#pragma unroll
            for (int m = 0; m < 4; ++m) { const int row = row0 + ai * HALF + m * 16;
                const float* bp = (row < split ? base0 + (size_t)row * DM : base1 + (size_t)(row - split) * DM) + col0; float* op = out + (size_t)row * DM + col0;
#pragma unroll
                for (int bj = 0; bj < 2; ++bj)
#pragma unroll
                    for (int n = 0; n < 2; ++n) { const f32x4 b = *(const f32x4*)(bp + bj * HALF + n * 16); *(f32x4*)(op + bj * HALF + n * 16) = b + gv[bj][n] * acc[ai][bj][m][n]; } }
    }
};

template <class Epi, class Sched>
__device__ __forceinline__ void gemm_phase(LAS unsigned char* lds, const Gemms g, const Sched& S, const Epi& E) {
    int tid_ = threadIdx.x; asm volatile("" : "+v"(tid_));
    const int tid = tid_, wid = __builtin_amdgcn_readfirstlane(tid >> 6), lane = tid & 63, wr = wid >> 2, wc = wid & 3, fr = lane & 15, fq = lane >> 4;
    const int K = g.K, nt = K / BK;
    unsigned voffA[2], voffB[2];
#pragma unroll
    for (int i = 0; i < 2; ++i) { int R, C; stage_rc(tid * 16 + i * 8192, R, C); const int Rb = Epi::PERM ? ((R & ~31) + perm32(R & 31)) : R;
        voffA[i] = (unsigned)(R * K + C) * 2u; voffB[i] = (unsigned)(Rb * K + C) * 2u; }
    const size_t kstep = (size_t)(BK * 2);
    const size_t hstep = (size_t)HALF * K * 2;
    const size_t tstep = 2 * hstep;
    const unsigned ldsw = (unsigned)wid * 1024u;
    const int aoff = lds_byte(wr * 64 + fr, fq * 8), boff = lds_byte(wc * 32 + fr, fq * 8);
#define PG8_SA(b, h) (((b) * 2 + (h)) * HTB)
#define PG8_SB(b, h) ((4 + (b) * 2 + (h)) * HTB)
#define PG8_STAGE(bufoff, gbase, voff) do { _Pragma("unroll") for (int _i = 0; _i < 2; ++_i) \
        __builtin_amdgcn_global_load_lds((const unsigned*)((const char*)(gbase) + (voff)[_i]), (LAS unsigned*)(lds + (bufoff) + ldsw + _i * 8192), 16, 0, 0); } while (0)
#define PG8_LDA(dst, b, h) do { _Pragma("unroll") for (int m = 0; m < 4; ++m) _Pragma("unroll") for (int k = 0; k < 2; ++k) dst[m][k] = *(const LAS bf16x8*)(lds + PG8_SA(b, h) + aoff + m * 2048 + k * 1024); } while (0)
#define PG8_LDB(dst, b, h) do { _Pragma("unroll") for (int n = 0; n < 2; ++n) _Pragma("unroll") for (int k = 0; k < 2; ++k) dst[n][k] = *(const LAS bf16x8*)(lds + PG8_SB(b, h) + boff + n * 2048 + k * 1024); } while (0)
#define PG8_MMA(ai, bj, At, Bt) do { __builtin_amdgcn_s_setprio(1); _Pragma("unroll") for (int m = 0; m < 4; ++m) _Pragma("unroll") for (int n = 0; n < 2; ++n) _Pragma("unroll") for (int k = 0; k < 2; ++k) \
        acc[ai][bj][m][n] = __builtin_amdgcn_mfma_f32_16x16x32_bf16(Bt[n][k], At[m][k], acc[ai][bj][m][n], 0, 0, 0); __builtin_amdgcn_s_setprio(0); } while (0)
#define PG8_WAIT_V(n) asm volatile("s_waitcnt vmcnt(" #n ")" ::: "memory")
#define PG8_WAIT_L(n) asm volatile("s_waitcnt lgkmcnt(" #n ")" ::: "memory")
#define PG8_BAR __builtin_amdgcn_s_barrier()
#define PG8_SCHED __builtin_amdgcn_sched_barrier(0)
#define PG8_ABASE(u) ((const char*)((u).gi >= 1 ? g.A1 : g.A0) + (size_t)(u).pm * tstep)
#define PG8_BBASE(u) ((const char*)((u).gi >= 1 ? g.B1 : g.B0) + (size_t)(u).pn * tstep)
    Unit cur, nxt; int ui = 0;
    if (!S.next(0, cur)) return;
    f32x4 acc[2][2][4][2];
#pragma unroll
    for (int a = 0; a < 2; ++a)
#pragma unroll
        for (int b = 0; b < 2; ++b)
#pragma unroll
            for (int m = 0; m < 4; ++m)
#pragma unroll
                for (int n = 0; n < 2; ++n) acc[a][b][m][n] = (f32x4){0.f, 0.f, 0.f, 0.f};
    bf16x8 At[4][2], B0[2][2], B1[2][2];
    const char* cA = PG8_ABASE(cur); const char* cB = PG8_BBASE(cur);
    PG8_STAGE(PG8_SB(0, 0), cB, voffB); PG8_STAGE(PG8_SB(0, 1), cB + hstep, voffB); PG8_STAGE(PG8_SA(0, 0), cA, voffA); PG8_STAGE(PG8_SA(0, 1), cA + hstep, voffA);
    if (wr == 1) PG8_BAR;
    PG8_WAIT_V(2); PG8_BAR;
    PG8_STAGE(PG8_SB(1, 0), cB + kstep, voffB); PG8_STAGE(PG8_SA(1, 0), cA + kstep, voffA); PG8_STAGE(PG8_SB(1, 1), cB + hstep + kstep, voffB);
    PG8_WAIT_V(6); PG8_BAR;
    for (;;) {
        const bool has_next = S.next(ui + 1, nxt);
        const char* nA = has_next ? PG8_ABASE(nxt) : cA; const char* nB = has_next ? PG8_BBASE(nxt) : cB;
        for (int t = 0; t < nt; t += 2) {
            const bool last = (t == nt - 2);
            const char* a1 = cA + (size_t)(t + 1) * kstep;
            const char* a2 = last ? nA : cA + (size_t)(t + 2) * kstep; const char* b2 = last ? nB : cB + (size_t)(t + 2) * kstep;
            const char* a3 = a2 + kstep; const char* b3 = b2 + kstep;
            PG8_LDB(B0, 0, 0); PG8_LDB(B1, 0, 1); PG8_SCHED; PG8_LDA(At, 0, 0); PG8_STAGE(PG8_SA(1, 1), a1 + hstep, voffA);
            PG8_WAIT_V(8); PG8_WAIT_L(0); PG8_BAR; PG8_MMA(0, 0, At, B0); PG8_MMA(0, 1, At, B1); PG8_BAR; PG8_SCHED;
            PG8_LDA(At, 0, 1); PG8_STAGE(PG8_SB(0, 0), b2, voffB); PG8_STAGE(PG8_SB(0, 1), b2 + hstep, voffB); PG8_STAGE(PG8_SA(0, 0), a2, voffA);
            PG8_WAIT_V(8); PG8_WAIT_L(0); PG8_BAR; PG8_MMA(1, 0, At, B0); PG8_MMA(1, 1, At, B1); PG8_BAR; PG8_SCHED;
            PG8_LDB(B0, 1, 0); PG8_LDB(B1, 1, 1); PG8_SCHED; PG8_LDA(At, 1, 0); PG8_STAGE(PG8_SA(0, 1), a2 + hstep, voffA);
            PG8_WAIT_V(8); PG8_WAIT_L(0); PG8_BAR; PG8_MMA(0, 0, At, B0); PG8_MMA(0, 1, At, B1); PG8_BAR; PG8_SCHED;
            PG8_LDA(At, 1, 1); PG8_STAGE(PG8_SB(1, 0), b3, voffB); PG8_STAGE(PG8_SB(1, 1), b3 + hstep, voffB); PG8_STAGE(PG8_SA(1, 0), a3, voffA);
            PG8_WAIT_V(8); PG8_WAIT_L(0); PG8_BAR; PG8_MMA(1, 0, At, B0); PG8_MMA(1, 1, At, B1); PG8_BAR; PG8_SCHED;
        }
        if (wr == 0) PG8_BAR;
        E(acc, cur, wr, wc, fr, fq);
        if (!has_next) break;
#pragma unroll
        for (int a = 0; a < 2; ++a)
#pragma unroll
            for (int b = 0; b < 2; ++b)
#pragma unroll
                for (int m = 0; m < 4; ++m)
#pragma unroll
                    for (int n = 0; n < 2; ++n) acc[a][b][m][n] = (f32x4){0.f, 0.f, 0.f, 0.f};
        cur = nxt; cA = nA; cB = nB; ++ui;
        if (wr == 1) PG8_BAR;
    }
    PG8_WAIT_V(0);
    PG8_BAR;
#undef PG8_SA
#undef PG8_SB
#undef PG8_STAGE
#undef PG8_LDA
#undef PG8_LDB
#undef PG8_MMA
#undef PG8_WAIT_V
#undef PG8_WAIT_L
#undef PG8_BAR
#undef PG8_SCHED
#undef PG8_ABASE
#undef PG8_BBASE
}
}

struct Args { const float* in[35]; float* out; unsigned char* ws; int pad0, pad1; };
enum { I_XP = 0, I_XS, I_CCKV, I_CKR, I_SGF, I_SGB, I_C, I_CCTX, I_WMOD, I_BMOD, I_LNMIX, I_WIN, I_HCW, I_HCB, I_HW1, I_HB1, I_HFREQ, I_HW2, I_HB2, I_HW3, I_HSKIP,
       I_WAF, I_BAF, I_WAB, I_BAB, I_GNORM, I_QNORM, I_WUQ, I_KVNORM, I_WUKV, I_WOUT, I_LNFFN, I_WF1, I_WF2, I_LNFIN };

struct Frame {
    LAS unsigned char* lds;
    int G, bid;
    const float* const* in; float* out; unsigned char* ws;
};
struct Ids { int tid, lane, wave; };
__device__ __forceinline__ Ids get_ids() { int t = threadIdx.x; asm volatile("" : "+v"(t)); Ids r; r.tid = t; r.lane = t & 63; r.wave = __builtin_amdgcn_readfirstlane(t >> 6); return r; }
#define WSP(T, off) ((T*)(F.ws + (off)))

__device__ __forceinline__ void transpose_item(const float* W, int ldn, int k0, int n0, bf16_t* WT, int ldk, int row0, LAS float* scr, int lane) {
    float v[32];
#pragma unroll
    for (int i = 0; i < 32; ++i) { const int kk = 2 * i + (lane >> 5); v[i] = W[(size_t)(k0 + kk) * ldn + n0 + (lane & 31)]; }
#pragma unroll
    for (int i = 0; i < 32; ++i) { const int kk = 2 * i + (lane >> 5); scr[kk * 33 + (lane & 31)] = v[i]; }
    asm volatile("s_waitcnt lgkmcnt(0)" ::: "memory");
    const int c = lane & 7;
#pragma unroll
    for (int j = 0; j < 4; ++j) { const int n = (lane >> 3) + 8 * j; const LAS float* s = scr + (8 * c) * 33 + n;
        u32x4 o; o.x = pk2(s[0 * 33], s[1 * 33]); o.y = pk2(s[2 * 33], s[3 * 33]); o.z = pk2(s[4 * 33], s[5 * 33]); o.w = pk2(s[6 * 33], s[7 * 33]);
        *(u32x4*)(WT + (size_t)(row0 + n) * ldk + k0 + 8 * c) = o; }
    asm volatile("s_waitcnt lgkmcnt(0)" ::: "memory");
}

__device__ __forceinline__ void p0_weights(Frame& F) {
    const Ids I = get_ids();
    LAS float* scr = (LAS float*)(F.lds + I.wave * 16384);
    const int gw = F.bid * 8 + I.wave, NGW = F.G * 8;
    constexpr int I_IN = 32 * 119, I_UQ = 6 * 48, I_UKV = 4 * 64, I_OUT = 32 * 64, I_F1 = 32 * 352, I_F2 = 88 * 64, I_L = I_IN + I_UQ + I_UKV + I_OUT + I_F1 + I_F2;
    for (int it = gw; it < 2 * I_L; it += NGW) {
        const int l = it / I_L; int r = it % I_L;
        if (r < I_IN) {
            const int kb = r / 119, nb = r % 119, n0 = nb * 32; const float* W = F.in[I_WIN] + (size_t)l * DM * 3808;
            bf16_t* WT = WSP(bf16_t, WS_WINT) + (size_t)l * NT_ * DM; bf16_t* WN = WSP(bf16_t, WS_WINN) + (size_t)l * NN_ * DM;
            if (n0 < 1536) transpose_item(W, 3808, kb * 64, n0, WT, DM, n0, scr, I.lane);
            else if (n0 < 1792) transpose_item(W, 3808, kb * 64, n0, WN, DM, UN_Q + (n0 - 1536), scr, I.lane);
            else if (n0 < 2048) { transpose_item(W, 3808, kb * 64, n0, WT, DM, UT_GK + (n0 - 1792), scr, I.lane); transpose_item(W, 3808, kb * 64, n0, WN, DM, UN_K + (n0 - 1792), scr, I.lane); }
            else if (n0 < 2560) transpose_item(W, 3808, kb * 64, n0, WT, DM, UT_GV + (n0 - 2048), scr, I.lane);
            else if (n0 < 3072) transpose_item(W, 3808, kb * 64, n0, WN, DM, UN_G + (n0 - 2560), scr, I.lane);
            else if (n0 < 3104) transpose_item(W, 3808, kb * 64, n0, WN, DM, UN_AF + (n0 - 3072), scr, I.lane);
            else if (n0 < 3488) transpose_item(W, 3808, kb * 64, n0, WN, DM, UN_CQ + (n0 - 3104), scr, I.lane);
            else if (n0 < 3744) transpose_item(W, 3808, kb * 64, n0, WN, DM, UN_CKV + (n0 - 3488), scr, I.lane);
            else transpose_item(W, 3808, kb * 64, n0, WN, DM, UN_KR + (n0 - 3744), scr, I.lane);
            continue; }
        r -= I_IN;
        if (r < I_UQ) { const int kb = r / 48, nb = r % 48; transpose_item(F.in[I_WUQ] + (size_t)l * 384 * 1536, 1536, kb * 64, nb * 32, WSP(bf16_t, WS_WUQ) + (size_t)l * 1536 * 384, 384, nb * 32, scr, I.lane); continue; }
        r -= I_UQ;
        if (r < I_UKV) { const int kb = r / 64, nb = r % 64, n0 = nb * 32, h = n0 >> 8, j = n0 & 255;
            if (j < 128) transpose_item(F.in[I_WUKV] + (size_t)l * 256 * 2048, 2048, kb * 64, n0, WSP(bf16_t, WS_WUK) + (size_t)l * 1024 * 256, 256, h * 128 + j, scr, I.lane);
            else transpose_item(F.in[I_WUKV] + (size_t)l * 256 * 2048, 2048, kb * 64, n0, WSP(bf16_t, WS_WUV) + (size_t)l * 1024 * 256, 256, h * 128 + (j - 128), scr, I.lane);
            continue; }
        r -= I_UKV;
        if (r < I_OUT) { const int kb = r / 64, nb = r % 64; transpose_item(F.in[I_WOUT] + (size_t)l * DM * DM, DM, kb * 64, nb * 32, WSP(bf16_t, WS_WOUT) + (size_t)l * DM * DM, DM, nb * 32, scr, I.lane); continue; }
        r -= I_OUT;
        if (r < I_F1) { const int kb = r / 352, nb = r % 352, n0 = nb * 32; const int up = n0 >= DFF, j = up ? n0 - DFF : n0;
            transpose_item(F.in[I_WF1] + (size_t)l * DM * 2 * DFF, 2 * DFF, kb * 64, n0, WSP(bf16_t, WS_WF1) + (size_t)l * 2 * DFF * DM, DM, 256 * (j >> 7) + (up ? 128 : 0) + (j & 127), scr, I.lane); continue; }
        r -= I_F1;
        { const int kb = r / 64, nb = r % 64; transpose_item(F.in[I_WF2] + (size_t)l * DFF * DM, DM, kb * 64, nb * 32, WSP(bf16_t, WS_WF2) + (size_t)l * DM * DFF, DFF, nb * 32, scr, I.lane); }
    }
    { const int gt = F.bid * 512 + I.tid, NT = F.G * 512;
      for (int i = gt; i < 2 * 8192; i += NT) { const int l = i / 8192, e = i % 8192; *(u32x4*)(WSP(bf16_t, WS_WINN) + (size_t)l * NN_ * DM + (size_t)1760 * DM + e * 8) = (u32x4){0u, 0u, 0u, 0u}; } }
    { const int gt = F.bid * 512 + I.tid, NT = F.G * 512;
      for (int i = gt; i < 2 * 2048 * 64; i += NT) { const int l = i / (2048 * 64), e = i % (2048 * 64), rr = e >> 6, c4 = (e & 63) * 4, b = rr >> 8, j = rr & 255;
          const f32x4 v = *(const f32x4*)(F.in[I_CCKV] + ((size_t)(b * 2 + l) * 256 + j) * 256 + c4);
          *(u32x2*)(WSP(bf16_t, WS_CKVN) + ((size_t)l * MKV + MT + rr) * 256 + c4) = (u32x2){pk2(v[0], v[1]), pk2(v[2], v[3])}; }
      for (int i = gt; i < 2 * 2048 * 16; i += NT) { const int l = i / (2048 * 16), e = i % (2048 * 16), rr = e >> 4, c4 = (e & 15) * 4, b = rr >> 8, j = rr & 255;
          const f32x4 v = *(const f32x4*)(F.in[I_CKR] + ((size_t)(b * 2 + l) * 256 + j) * 64 + c4);
          *(u32x2*)(WSP(bf16_t, WS_KRB) + ((size_t)l * MKV + MT + rr) * 64 + c4) = (u32x2){pk2(v[0], v[1]), pk2(v[2], v[3])}; } }
}

__device__ __forceinline__ void p0_mod(Frame& F) {
    const Ids I = get_ids();
    LAS float* sc = (LAS float*)F.lds;
    LAS float* red = (LAS float*)(F.lds + 9 * 2048 * 4);
    for (int i = I.tid; i < 9 * 2048; i += 512) { const int r = i >> 11, k = i & 2047; const float c = r < 8 ? F.in[I_C][r * 2048 + k] : F.in[I_CCTX][k]; sc[i] = siluf(c); }
    __syncthreads();
    for (int it = F.bid; it < 2 * 384; it += F.G) {
        const int l = it / 384, n0 = (it % 384) * 32, col = n0 + (I.lane & 31), kp = I.lane >> 5;
        const float* W = F.in[I_WMOD] + (size_t)l * DM * NMOD + col;
        float acc[9];
#pragma unroll
        for (int r = 0; r < 9; ++r) acc[r] = 0.f;
        const int kbase = I.wave * 256;
#pragma unroll 8
        for (int i = 0; i < 128; ++i) { const int k = kbase + 2 * i + kp; const float w = W[(size_t)k * NMOD];
#pragma unroll
            for (int r = 0; r < 9; ++r) acc[r] += sc[r * 2048 + k] * w; }
#pragma unroll
        for (int r = 0; r < 9; ++r) { acc[r] += __shfl_xor(acc[r], 32); if (I.lane < 32) red[(I.wave * 9 + r) * 32 + I.lane] = acc[r]; }
        __syncthreads();
        if (I.tid < 288) { const int r = I.tid >> 5, c = I.tid & 31; float s = 0.f;
#pragma unroll
            for (int w = 0; w < 8; ++w) s += red[(w * 9 + r) * 32 + c];
            WSP(float, WS_MOD)[((size_t)l * 9 + r) * NMOD + n0 + c] = s + F.in[I_BMOD][(size_t)l * NMOD + n0 + c]; }
        __syncthreads();
    }
}

__device__ __forceinline__ void p0_filters(Frame& F) {
    const Ids I = get_ids();
    LAS float* scr = (LAS float*)(F.lds + 90112 + I.wave * 6144);
    LAS float* zb = scr; LAS float* h1 = scr + 8 * 33; LAS float* h2 = h1 + 8 * 64;
    const int gw = F.bid * 8 + I.wave, NGW = F.G * 8, lane = I.lane;
    for (int it = gw; it < 2 * 160; it += NGW) {
        const int l = it / 160, r = it % 160, grp = r >= 32, tb = grp ? r - 32 : r, L = grp ? 1024 : 256, t0 = tb * 8;
        const float* w1 = F.in[I_HW1] + l * 33 * 64; const float* b1 = F.in[I_HB1] + l * 64; const float* fr = F.in[I_HFREQ] + l * 128;
        const float* w2 = F.in[I_HW2] + l * 64 * 64; const float* b2 = F.in[I_HB2] + l * 64; const float* w3 = F.in[I_HW3] + (size_t)l * 64 * 2048;
        for (int e = lane; e < 8 * 33; e += 64) { const int tt = e / 33, j = e % 33, t = t0 + tt; float z;
            if (j == 0) z = (float)t / (float)(L - 1);
            else { const int band = (j - 1) & 15; const float f = 1e-4f + (float)band * ((15.f - 1e-4f) / 15.f); float turns = f * (float)t / (float)L; turns -= floorf(turns);
                   z = j <= 16 ? cos_turns(turns) : -sin_turns(turns); }
            zb[e] = z; }
        asm volatile("s_waitcnt lgkmcnt(0)" ::: "memory");
        { float a[8];
#pragma unroll
          for (int tt = 0; tt < 8; ++tt) a[tt] = b1[lane];
          for (int i = 0; i < 33; ++i) { const float w = w1[i * 64 + lane];
#pragma unroll
              for (int tt = 0; tt < 8; ++tt) a[tt] += zb[tt * 33 + i] * w; }
          const float f0 = fr[lane];
#pragma unroll
          for (int tt = 0; tt < 8; ++tt) h1[tt * 64 + lane] = sin_rad(f0 * a[tt]); }
        asm volatile("s_waitcnt lgkmcnt(0)" ::: "memory");
        { float a[8];
#pragma unroll
          for (int tt = 0; tt < 8; ++tt) a[tt] = b2[lane];
          for (int i = 0; i < 64; ++i) { const float w = w2[i * 64 + lane];
#pragma unroll
              for (int tt = 0; tt < 8; ++tt) a[tt] += h1[tt * 64 + i] * w; }
          const float f1 = fr[64 + lane];
#pragma unroll
          for (int tt = 0; tt < 8; ++tt) h2[tt * 64 + lane] = sin_rad(f1 * a[tt]); }
        asm volatile("s_waitcnt lgkmcnt(0)" ::: "memory");
        bf16_t* HF = WSP(bf16_t, WS_HF) + (size_t)l * HF_L + (grp ? (size_t)2 * 512 * 512 : 0);
        for (int q = 0; q < 32; ++q) { const int n = q * 64 + lane, side = n >> 10, o = (n >> 9) & 1, c = n & 511;
            float a[8];
#pragma unroll
            for (int tt = 0; tt < 8; ++tt) a[tt] = 0.f;
            for (int i = 0; i < 64; ++i) { const float w = w3[(size_t)i * 2048 + n];
#pragma unroll
                for (int tt = 0; tt < 8; ++tt) a[tt] += h2[tt * 64 + i] * w; }
            const float delta = 3.0701134573f + (float)c * ((15.3505672866f - 3.0701134573f) / 511.f);
            bf16_t* dst = HF + ((size_t)o * 512 + c) * (2 * L) + L;
#pragma unroll
            for (int tt = 0; tt < 8; ++tt) { const int t = t0 + tt; const float tl = (float)t / (float)(L - 1); const float v = a[tt] * __expf(-tl * delta);
                if (side == 0) dst[-t] = (bf16_t)f2bf(v); else if (t > 0) dst[t] = (bf16_t)f2bf(v); else dst[-L] = 0; } }
        asm volatile("s_waitcnt lgkmcnt(0)" ::: "memory");
    }
}

__device__ __forceinline__ void phase_norm(Frame& F, int l, const float* x0, const float* x1, int split, const float* ln, int sc_off, int sh_off) {
    const Ids I = get_ids();
    const int gw = F.bid * 8 + I.wave, NGW = F.G * 8;
    bf16_t* XN = WSP(bf16_t, WS_XN);
    for (int m = gw; m < MT; m += NGW) {
        const float* xr = m < split ? x0 + (size_t)m * DM : x1 + (size_t)(m - split) * DM;
        const int r9 = m < MC ? 8 : ((m - MC) >> 10);
        const float* mod = WSP(float, WS_MOD) + ((size_t)l * 9 + r9) * NMOD;
        f32x4 v[8]; float ss = 0.f;
#pragma unroll
        for (int j = 0; j < 8; ++j) { v[j] = *(const f32x4*)(xr + 4 * (64 * j + I.lane)); ss += (v[j][0] * v[j][0] + v[j][1] * v[j][1]) + (v[j][2] * v[j][2] + v[j][3] * v[j][3]); }
        const float rstd = 1.f / sqrtf(wave_sum(ss) * (1.f / DM) + EPS);
#pragma unroll
        for (int j = 0; j < 8; ++j) { const int col = 4 * (64 * j + I.lane);
            const f32x4 g = *(const f32x4*)(ln + col), sc = *(const f32x4*)(mod + sc_off + col), sh = *(const f32x4*)(mod + sh_off + col);
            const f32x4 y = v[j] * rstd * g * (sc + 1.f) + sh;
            *(u32x2*)(XN + (size_t)m * DM + col) = (u32x2){pk2(y[0], y[1]), pk2(y[2], y[3])}; }
    }
}
__device__ __forceinline__ void phase_final(Frame& F, const float* x, const float* ln) {
    const Ids I = get_ids();
    const int gw = F.bid * 8 + I.wave, NGW = F.G * 8;
    for (int m = gw; m < MT; m += NGW) {
        const float* xr = x + (size_t)m * DM;
        f32x4 v[8]; float ss = 0.f;
#pragma unroll
        for (int j = 0; j < 8; ++j) { v[j] = *(const f32x4*)(xr + 4 * (64 * j + I.lane)); ss += (v[j][0] * v[j][0] + v[j][1] * v[j][1]) + (v[j][2] * v[j][2] + v[j][3] * v[j][3]); }
        const float rstd = 1.f / sqrtf(wave_sum(ss) * (1.f / DM) + EPS);
#pragma unroll
        for (int j = 0; j < 8; ++j) { const int col = 4 * (64 * j + I.lane); const f32x4 g = *(const f32x4*)(ln + col);
            *(f32x4*)(F.out + O_Y + (size_t)m * DM + col) = v[j] * rstd * g; }
    }
}

__device__ __forceinline__ void phase_prep(Frame& F, int l) {
    const Ids I = get_ids();
    const int gw = F.bid * 8 + I.wave, NGW = F.G * 8, lane = I.lane;
    const bf16_t* UN = WSP(bf16_t, WS_UN);
    const float* qn = F.in[I_QNORM] + l * 384; const float* kvn = F.in[I_KVNORM] + l * 256;
    for (int m = gw; m < MT; m += NGW) {
        const bf16_t* ur = UN + (size_t)m * NN_;
        { const unsigned* p = (const unsigned*)(ur + UN_CQ + 6 * lane); const unsigned w0 = p[0], w1 = p[1], w2 = p[2];
          float v[6] = {lo16(w0), hi16(w0), lo16(w1), hi16(w1), lo16(w2), hi16(w2)}; float ss = 0.f;
#pragma unroll
          for (int i = 0; i < 6; ++i) ss += v[i] * v[i];
          const float rstd = 1.f / sqrtf(wave_sum(ss) * (1.f / 384.f) + EPS);
          unsigned* o = (unsigned*)(WSP(bf16_t, WS_CQN) + (size_t)m * 384 + 6 * lane);
#pragma unroll
          for (int i = 0; i < 3; ++i) o[i] = pk2(v[2 * i] * rstd * qn[6 * lane + 2 * i], v[2 * i + 1] * rstd * qn[6 * lane + 2 * i + 1]); }
        { const u32x2 w = *(const u32x2*)(ur + UN_CKV + 4 * lane); float v[4] = {lo16(w.x), hi16(w.x), lo16(w.y), hi16(w.y)};
          const float ss = v[0] * v[0] + v[1] * v[1] + v[2] * v[2] + v[3] * v[3];
          const float rstd = 1.f / sqrtf(wave_sum(ss) * (1.f / 256.f) + EPS);
          const f32x4 g = *(const f32x4*)(kvn + 4 * lane); const f32x4 y = {v[0] * rstd * g[0], v[1] * rstd * g[1], v[2] * rstd * g[2], v[3] * rstd * g[3]};
          *(u32x2*)(WSP(bf16_t, WS_CKVN) + ((size_t)l * MKV + m) * 256 + 4 * lane) = (u32x2){pk2(y[0], y[1]), pk2(y[2], y[3])};
          if (m < MC) { const int b = m >> 8, t = m & 255; *(f32x4*)(F.out + O_CKV + ((size_t)(b * 2 + l) * 256 + t) * 256 + 4 * lane) = y; } }
        { const float v = bf2f(ur[UN_KR + lane]); float o = v;
          if (m < MC) { const int b = m >> 8, t = m & 255; F.out[O_KR + ((size_t)(b * 2 + l) * 256 + t) * 64 + lane] = v; }
          else { const int t = (m - MC) & 1023; const int pos = lane < 32 ? (t >> 6) : (t & 63); const int i = lane & 15;
                 const float inv = __builtin_amdgcn_exp2f(-(float)i * (13.287712379549449f / 16.f));
                 float turns = (float)pos * inv * 0.15915494309189535f; turns -= floorf(turns);
                 const float cs = cos_turns(turns), sn = sin_turns(turns); const float pv = __shfl_xor(v, 16);
                 o = (lane & 16) ? (pv * sn + v * cs) : (v * cs - pv * sn); }
          WSP(bf16_t, WS_KRB)[((size_t)l * MKV + m) * 64 + lane] = (bf16_t)f2bf(o); }
    }
}

constexpr int KSTR = 400, VSTR = 136;
constexpr int KTILE = 64 * KSTR, VTILE = 128 * VSTR, ABUF = KTILE + VTILE;
__device__ __forceinline__ void attn_unit(Frame& F, int l, int grp, int b, int h, int qb) {
    const Ids I = get_ids();
    const int tid = I.tid, lane = I.lane, wave = I.wave, r32 = lane & 31, hi = lane >> 5;
    const bf16_t* Q = WSP(bf16_t, WS_Q); const bf16_t* KN = WSP(bf16_t, WS_KN); const bf16_t* VT = WSP(bf16_t, WS_VT); const bf16_t* KR = WSP(bf16_t, WS_KRB) + (size_t)l * MKV * 64;
    const int qrow0 = grp ? MC + b * 1024 + qb * 256 : b * 256;
    const int ntile = grp ? 20 : 4;
    const int qrow = qrow0 + wave * 32 + r32;
    bf16x8 qr[12];
#pragma unroll
    for (int s = 0; s < 12; ++s) qr[s] = *(const bf16x8*)(Q + (size_t)qrow * 1536 + h * 192 + 16 * s + 8 * hi);
    if (grp) {
        const int t = (qrow - MC) & 1023;
#pragma unroll
        for (int half = 0; half < 2; ++half) { const int pos = half ? (t & 63) : (t >> 6);
#pragma unroll
            for (int j = 0; j < 8; ++j) { const int i = 8 * hi + j; const float inv = __builtin_amdgcn_exp2f(-(float)i * (13.287712379549449f / 16.f));
                float turns = (float)pos * inv * 0.15915494309189535f; turns -= floorf(turns); const float cs = cos_turns(turns), sn = sin_turns(turns);
                const float x1 = bf2f((bf16_t)qr[8 + 2 * half][j]), x2 = bf2f((bf16_t)qr[9 + 2 * half][j]);
                qr[8 + 2 * half][j] = (short)f2bf(x1 * cs - x2 * sn); qr[9 + 2 * half][j] = (short)f2bf(x1 * sn + x2 * cs); } }
    }
    f32x16 o[4];
#pragma unroll
    for (int d = 0; d < 4; ++d) o[d] = (f32x16){};
    float m_run = -1e30f, l_run = 0.f;
    constexpr float C = 0.07216878364870322f * 1.4426950408889634f;
    u32x4 sk0, sk1, skr, sv0, sv1;
    auto key_base = [&](int tb) -> int { return grp ? (tb < 16 ? MC + b * 1024 + tb * 64 : MT + b * 256 + (tb - 16) * 64) : b * 256 + tb * 64; };
    auto gload = [&](int tb) { const int kb = key_base(tb);
        { const int e = tid, row = e >> 4, ch = e & 15; sk0 = *(const u32x4*)(KN + (size_t)(kb + row) * 1024 + h * 128 + ch * 8); }
        { const int e = tid + 512, row = e >> 4, ch = e & 15; sk1 = *(const u32x4*)(KN + (size_t)(kb + row) * 1024 + h * 128 + ch * 8); }
        { const int row = tid >> 3, ch = tid & 7; skr = *(const u32x4*)(KR + (size_t)(kb + row) * 64 + ch * 8); }
        { const int e = tid, row = e >> 3, ch = e & 7; sv0 = *(const u32x4*)(VT + (size_t)(h * 128 + row) * MKV + kb + ch * 8); }
        { const int e = tid + 512, row = e >> 3, ch = e & 7; sv1 = *(const u32x4*)(VT + (size_t)(h * 128 + row) * MKV + kb + ch * 8); } };
    auto lstore = [&](int buf) { LAS unsigned char* kb = F.lds + buf * ABUF; LAS unsigned char* vb = kb + KTILE;
        { const int e = tid, row = e >> 4, ch = e & 15; *(LAS u32x4*)(kb + row * KSTR + ch * 16) = sk0; }
        { const int e = tid + 512, row = e >> 4, ch = e & 15; *(LAS u32x4*)(kb + row * KSTR + ch * 16) = sk1; }
        { const int row = tid >> 3, ch = tid & 7; *(LAS u32x4*)(kb + row * KSTR + 256 + ch * 16) = skr; }
        { const int e = tid, row = e >> 3, ch = e & 7; *(LAS u32x2*)(vb + row * VSTR + ch * 16) = (u32x2){sv0.x, sv0.y}; *(LAS u32x2*)(vb + row * VSTR + ch * 16 + 8) = (u32x2){sv0.z, sv0.w}; }
        { const int e = tid + 512, row = e >> 3, ch = e & 7; *(LAS u32x2*)(vb + row * VSTR + ch * 16) = (u32x2){sv1.x, sv1.y}; *(LAS u32x2*)(vb + row * VSTR + ch * 16 + 8) = (u32x2){sv1.z, sv1.w}; } };
    __syncthreads();
    gload(0); lstore(0); __syncthreads();
    for (int tb = 0; tb < ntile; ++tb) {
        const int buf = tb & 1;
        if (tb + 1 < ntile) gload(tb + 1);
        LAS unsigned char* kb = F.lds + buf * ABUF; LAS unsigned char* vb = kb + KTILE;
        f32x16 p0 = (f32x16){}, p1 = (f32x16){};
#pragma unroll
        for (int s = 0; s < 12; ++s) {
            const bf16x8 k0 = *(const LAS bf16x8*)(kb + r32 * KSTR + (16 * s + 8 * hi) * 2);
            const bf16x8 k1 = *(const LAS bf16x8*)(kb + (32 + r32) * KSTR + (16 * s + 8 * hi) * 2);
            p0 = __builtin_amdgcn_mfma_f32_32x32x16_bf16(k0, qr[s], p0, 0, 0, 0);
            p1 = __builtin_amdgcn_mfma_f32_32x32x16_bf16(k1, qr[s], p1, 0, 0, 0);
        }
        float pmax = p0[0];
#pragma unroll
        for (int r = 1; r < 16; ++r) pmax = fmaxf(pmax, p0[r]);
#pragma unroll
        for (int r = 0; r < 16; ++r) pmax = fmaxf(pmax, p1[r]);
        pmax = fmaxf(pmax, __shfl_xor(pmax, 32));
        const float mn = fmaxf(m_run, pmax); const float alpha = __builtin_amdgcn_exp2f((m_run - mn) * C); m_run = mn;
        const float mnC = -mn * C; float ps = 0.f;
#pragma unroll
        for (int r = 0; r < 16; ++r) { p0[r] = __builtin_amdgcn_exp2f(fmaf(p0[r], C, mnC)); p1[r] = __builtin_amdgcn_exp2f(fmaf(p1[r], C, mnC)); ps += p0[r] + p1[r]; }
        l_run = l_run * alpha + ps;
#pragma unroll
        for (int d = 0; d < 4; ++d)
#pragma unroll
            for (int r = 0; r < 16; ++r) o[d][r] *= alpha;
        bf16x8 pb[4];
#pragma unroll
        for (int ks = 0; ks < 4; ++ks) { u32x4 w;
#pragma unroll
            for (int jj = 0; jj < 4; ++jj) { const int r = (ks & 1) * 8 + 2 * jj; const float a = ks < 2 ? p0[r] : p1[r], bq = ks < 2 ? p0[r + 1] : p1[r + 1]; w[jj] = pg8::cvt_pk_bf16(a, bq); }
            pb[ks] = __builtin_bit_cast(bf16x8, w); }
#pragma unroll
        for (int d = 0; d < 4; ++d)
#pragma unroll
            for (int ks = 0; ks < 4; ++ks) { const LAS unsigned char* vp = vb + (32 * d + r32) * VSTR + (16 * ks + 4 * hi) * 2;
                const s16x4 lo = *(const LAS s16x4*)vp, hh = *(const LAS s16x4*)(vp + 16);
                const bf16x8 va = (bf16x8){lo[0], lo[1], lo[2], lo[3], hh[0], hh[1], hh[2], hh[3]};
                o[d] = __builtin_amdgcn_mfma_f32_32x32x16_bf16(va, pb[ks], o[d], 0, 0, 0); }
        if (tb + 1 < ntile) lstore(buf ^ 1);
        __syncthreads();
    }
    const float lt = l_run + __shfl_xor(l_run, 32); const float rl = 1.f / lt;
    bf16_t* yo = WSP(bf16_t, WS_YMIX) + (size_t)qrow * DM + 1024 + h * 128;
#pragma unroll
    for (int d = 0; d < 4; ++d)
#pragma unroll
        for (int g4 = 0; g4 < 4; ++g4) { const int dv = 32 * d + 8 * g4 + 4 * hi;
            *(u32x2*)(yo + dv) = (u32x2){pk2(o[d][4 * g4] * rl, o[d][4 * g4 + 1] * rl), pk2(o[d][4 * g4 + 2] * rl, o[d][4 * g4 + 3] * rl)}; }
}
__device__ __forceinline__ void phase_attn(Frame& F, int l) {
    for (int u = F.bid; u < 384; u += F.G) {
        if (u < 256) attn_unit(F, l, 1, u >> 5, (u >> 2) & 7, u & 3);
        else { const int v = u - 256; attn_unit(F, l, 0, v >> 3, v & 7, 0); }
    }
    __syncthreads();
}

__device__ __forceinline__ void gla_unit(Frame& F, int l, int grp, int b, int h, int dir) {
    const Ids I = get_ids();
    const int tid = I.tid, lane = I.lane, wave = I.wave, li = lane & 15, lg = lane >> 4;
    constexpr int SQ = 144;
    constexpr int O_QD = 0, O_KI = 9216, O_KET = 18432, O_ATT = 27648, O_VT = 36864, O_AF = 55296, O_TOT = 59392, O_DEC = 61440;
    const int L = grp ? 1024 : 256, row0 = grp ? MC + b * 1024 : b * 256, NCH = L / 64;
    const bf16_t* UN = WSP(bf16_t, WS_UN); const bf16_t* UT = WSP(bf16_t, WS_UT);
    const float* wa = (dir ? F.in[I_WAB] : F.in[I_WAF]) + l * 16 * 256 + h * 64 + lane; const float ba_d = ((dir ? F.in[I_BAB] : F.in[I_BAF]) + l * 256 + h * 64)[lane];
    const int afo = dir ? UN_AB : UN_AF;
    float* Oo = WSP(float, dir ? WS_OB : WS_OF);
    LAS unsigned char* lds = F.lds;
    float war[16];
#pragma unroll
    for (int r = 0; r < 16; ++r) war[r] = wa[r * 256];
    f32x4 S[4];
    if (grp) { const float* st = (dir ? F.in[I_SGB] : F.in[I_SGF]) + ((size_t)((b * 2 + l) * 4 + h) * 64) * 128 + 16 * wave + li;
#pragma unroll
        for (int td = 0; td < 4; ++td)
#pragma unroll
            for (int r = 0; r < 4; ++r) S[td][r] = st[(size_t)(16 * td + 4 * lg + r) * 128]; }
    else {
#pragma unroll
        for (int td = 0; td < 4; ++td) S[td] = (f32x4){0.f, 0.f, 0.f, 0.f}; }
#pragma unroll 1
    for (int cc = 0; cc < NCH; ++cc) {
        const int n = dir ? NCH - 1 - cc : cc, tb = row0 + 64 * n;
        __syncthreads();
#pragma unroll
        for (int e2 = 0; e2 < 2; ++e2) { const int e = tid + 512 * e2, i = e >> 4, r = e & 15; ((LAS float*)(lds + O_AF))[e] = bf2f(UN[(size_t)(tb + i) * NN_ + afo + r]); }
#pragma unroll
        for (int p2 = 0; p2 < 2; ++p2) { const int p = tid + 512 * p2, dv = p >> 3, c8 = (p & 7) * 8;
            *(LAS u32x4*)(lds + O_VT + dv * SQ + c8 * 2) = *(const u32x4*)(UT + (size_t)(UT_GV + h * 128 + dv) * MT + tb + c8); }
        float qv[8], kv[8];
#pragma unroll
        for (int m = 0; m < 8; ++m) { const bf16_t* ur = UN + (size_t)(tb + 8 * wave + m) * NN_ + h * 64 + lane; qv[m] = bf2f(ur[UN_Q]) * 0.125f; kv[m] = bf2f(ur[UN_K]); }
        __syncthreads();
        float g[8];
#pragma unroll
        for (int m = 0; m < 8; ++m) { const LAS f32x4* ap = (const LAS f32x4*)(lds + O_AF + (8 * wave + m) * 64); float x = ba_d;
#pragma unroll
            for (int r4 = 0; r4 < 4; ++r4) { const f32x4 a4 = ap[r4]; x += a4[0] * war[4 * r4] + a4[1] * war[4 * r4 + 1] + a4[2] * war[4 * r4 + 2] + a4[3] * war[4 * r4 + 3]; }
            g[m] = (fminf(x, 0.f) - __logf(1.f + __expf(-fabsf(x)))) * (1.f / 16.f); }
        if (dir == 0) {
#pragma unroll
            for (int m = 1; m < 8; ++m) g[m] += g[m - 1];
        } else {
#pragma unroll
            for (int m = 6; m >= 0; --m) g[m] += g[m + 1];
        }
        ((LAS float*)(lds + O_TOT))[wave * 64 + lane] = dir == 0 ? g[7] : g[0];
        __syncthreads();
        float off = 0.f, gtot = 0.f;
#pragma unroll
        for (int w2 = 0; w2 < 8; ++w2) { const float tv = ((const LAS float*)(lds + O_TOT))[w2 * 64 + lane]; gtot += tv; if (dir == 0 ? (w2 < wave) : (w2 > wave)) off += tv; }
        { unsigned kw[4];
#pragma unroll
          for (int m = 0; m < 8; ++m) { const float G = g[m] + off; const float eg = __expf(G), eng = __expf(-G), ee = __expf(gtot - G);
              ((LAS bf16_t*)(lds + O_QD + (8 * wave + m) * SQ))[lane] = (bf16_t)f2bf(qv[m] * eg);
              ((LAS bf16_t*)(lds + O_KI + (8 * wave + m) * SQ))[lane] = (bf16_t)f2bf(kv[m] * eng);
              const unsigned hv = f2bf(kv[m] * ee); if (m & 1) kw[m >> 1] |= hv << 16; else kw[m >> 1] = hv; }
          *(LAS u32x4*)(lds + O_KET + lane * SQ + wave * 16) = (u32x4){kw[0], kw[1], kw[2], kw[3]};
          if (wave == 0) ((LAS float*)(lds + O_DEC))[lane] = __expf(gtot); }
        __syncthreads();
        { const int ti = wave >> 1;
#pragma unroll
          for (int t2 = 0; t2 < 2; ++t2) { const int tj = 2 * (wave & 1) + t2; f32x4 c = (f32x4){0.f, 0.f, 0.f, 0.f};
              const bool live = dir == 0 ? (tj <= ti) : (tj >= ti);
              if (live) {
#pragma unroll
                  for (int kk = 0; kk < 2; ++kk) { const bf16x8 af = *(const LAS bf16x8*)(lds + O_KI + (16 * tj + li) * SQ + (32 * kk + 8 * lg) * 2);
                      const bf16x8 bfr = *(const LAS bf16x8*)(lds + O_QD + (16 * ti + li) * SQ + (32 * kk + 8 * lg) * 2);
                      c = __builtin_amdgcn_mfma_f32_16x16x32_bf16(af, bfr, c, 0, 0, 0); }
                  if (tj == ti) { const int ii = li;
#pragma unroll
                      for (int r = 0; r < 4; ++r) { const int jj = 4 * lg + r; const bool keep = dir == 0 ? (jj <= ii) : (jj >= ii); if (!keep) c[r] = 0.f; } } }
              *(LAS u32x2*)(lds + O_ATT + (16 * ti + li) * SQ + (16 * tj + 4 * lg) * 2) = (u32x2){pk2(c[0], c[1]), pk2(c[2], c[3])}; } }
        __syncthreads();
        { bf16x8 bv[2];
#pragma unroll
          for (int kk = 0; kk < 2; ++kk) bv[kk] = *(const LAS bf16x8*)(lds + O_VT + (16 * wave + li) * SQ + (32 * kk + 8 * lg) * 2);
          bf16x8 bs[2];
#pragma unroll
          for (int kk = 0; kk < 2; ++kk) { const u32x4 w4 = (u32x4){pk2(S[2 * kk][0], S[2 * kk][1]), pk2(S[2 * kk][2], S[2 * kk][3]), pk2(S[2 * kk + 1][0], S[2 * kk + 1][1]), pk2(S[2 * kk + 1][2], S[2 * kk + 1][3])};
              bs[kk] = __builtin_bit_cast(bf16x8, w4); }
#pragma unroll
          for (int ti = 0; ti < 4; ++ti) { f32x4 acc = (f32x4){0.f, 0.f, 0.f, 0.f};
#pragma unroll
              for (int kk = 0; kk < 2; ++kk) { const bf16x8 af = *(const LAS bf16x8*)(lds + O_ATT + (16 * ti + li) * SQ + (32 * kk + 8 * lg) * 2);
                  acc = __builtin_amdgcn_mfma_f32_16x16x32_bf16(af, bv[kk], acc, 0, 0, 0); }
#pragma unroll
              for (int kk = 0; kk < 2; ++kk) { const LAS unsigned char* qp = lds + O_QD + (16 * ti + li) * SQ + (32 * kk + 4 * lg) * 2;
                  const s16x4 lo = *(const LAS s16x4*)qp, hh = *(const LAS s16x4*)(qp + 32);
                  const bf16x8 af = (bf16x8){lo[0], lo[1], lo[2], lo[3], hh[0], hh[1], hh[2], hh[3]};
                  acc = __builtin_amdgcn_mfma_f32_16x16x32_bf16(af, bs[kk], acc, 0, 0, 0); }
              float* op = Oo + (size_t)(tb + 16 * ti + 4 * lg) * 512 + h * 128 + 16 * wave + li;
#pragma unroll
              for (int r = 0; r < 4; ++r) op[(size_t)r * 512] = acc[r]; }
#pragma unroll
          for (int td = 0; td < 4; ++td) { const f32x4 dc = *(const LAS f32x4*)(lds + O_DEC + (16 * td + 4 * lg) * 4); f32x4 c = S[td] * dc;
#pragma unroll
              for (int kk = 0; kk < 2; ++kk) { const bf16x8 af = *(const LAS bf16x8*)(lds + O_KET + (16 * td + li) * SQ + (32 * kk + 8 * lg) * 2);
                  c = __builtin_amdgcn_mfma_f32_16x16x32_bf16(af, bv[kk], c, 0, 0, 0); }
              S[td] = c; } }
    }
    if (!grp) { float* so = F.out + (dir ? O_GB : O_GF) + ((size_t)((b * 2 + l) * 4 + h) * 64) * 128 + 16 * wave + li;
#pragma unroll
        for (int td = 0; td < 4; ++td)
#pragma unroll
            for (int r = 0; r < 4; ++r) so[(size_t)(16 * td + 4 * lg + r) * 128] = S[td][r]; }
}
__device__ __forceinline__ void phase_gla(Frame& F, int l) {
    for (int u = F.bid; u < 192; u += F.G) {
        if (u < 64) gla_unit(F, l, 1, u >> 3, (u >> 1) & 3, u & 1);
        else { const int v = u - 64; gla_unit(F, l, 0, v >> 3, (v >> 1) & 3, v & 1); }
    }
    __syncthreads();
}
__device__ __forceinline__ void phase_gla_combine(Frame& F, int l) {
    const Ids I = get_ids();
    const int gw = F.bid * 8 + I.wave, NGW = F.G * 8, lane = I.lane;
    const float* gn = F.in[I_GNORM] + l * 128;
    for (int m = gw; m < MT; m += NGW) {
        const float* pf = WSP(float, WS_OF) + (size_t)m * 512 + 8 * lane; const float* pb = WSP(float, WS_OB) + (size_t)m * 512 + 8 * lane;
        const f32x4 a0 = *(const f32x4*)pf, a1 = *(const f32x4*)(pf + 4), b0 = *(const f32x4*)pb, b1 = *(const f32x4*)(pb + 4);
        float o[8] = {a0[0] + b0[0], a0[1] + b0[1], a0[2] + b0[2], a0[3] + b0[3], a1[0] + b1[0], a1[1] + b1[1], a1[2] + b1[2], a1[3] + b1[3]};
        float ss = 0.f;
#pragma unroll
        for (int i = 0; i < 8; ++i) ss += o[i] * o[i];
        ss += __shfl_xor(ss, 1); ss += __shfl_xor(ss, 2); ss += __shfl_xor(ss, 4); ss += __shfl_xor(ss, 8);
        const float rstd = 1.f / sqrtf(ss * (1.f / 128.f) + EPS);
        const u32x4 gw4 = *(const u32x4*)(WSP(bf16_t, WS_UN) + (size_t)m * NN_ + UN_G + 8 * lane);
        const float gg[8] = {lo16(gw4.x), hi16(gw4.x), lo16(gw4.y), hi16(gw4.y), lo16(gw4.z), hi16(gw4.z), lo16(gw4.w), hi16(gw4.w)};
        const int dv0 = (8 * lane) & 127; float y[8];
#pragma unroll
        for (int i = 0; i < 8; ++i) y[i] = o[i] * rstd * gn[dv0 + i] * siluf(gg[i]);
        *(u32x4*)(WSP(bf16_t, WS_YMIX) + (size_t)m * DM + 512 + 8 * lane) = (u32x4){pk2(y[0], y[1]), pk2(y[2], y[3]), pk2(y[4], y[5]), pk2(y[6], y[7])};
    }
}

template <int GRP> __device__ __forceinline__ void hyena_unit(Frame& F, int l, int c) {
    const Ids I = get_ids();
    constexpr int L = GRP ? 1024 : 256, NB = GRP ? 8 : 16, NTT = L / 128, ZSTR = 2 * L + 16;
    constexpr int O_HR = 0, O_RT = 2 * L * 16, O_ZA = O_RT + 4 * L, O_ZB = O_ZA + NB * ZSTR, O_G1 = O_ZB + NB * ZSTR, O_G2 = O_G1 + NB * ZSTR;
    static_assert(O_G2 + NB * ZSTR <= 131072, "hyena LDS");
    const int tid = I.tid, lane = I.lane, wave = I.wave, li = lane & 15, lg = lane >> 4;
    const bf16_t* UT = WSP(bf16_t, WS_UT);
    const float* cw = F.in[I_HCW] + (size_t)l * 3 * 1536; const float* cb = F.in[I_HCB] + (size_t)l * 1536;
    const bf16_t* RF = WSP(bf16_t, WS_HF) + (size_t)l * HF_L + (GRP ? (size_t)2 * 512 * 512 : 0);
    LAS unsigned char* lds = F.lds;
    __syncthreads();
    auto stage_rt = [&](int o) { if (tid < 2 * L / 8) *(LAS u32x4*)(lds + O_RT + tid * 16) = *(const u32x4*)(RF + ((size_t)o * 512 + c) * (2 * L) + tid * 8); };
    stage_rt(0);
#pragma unroll
    for (int a3 = 0; a3 < 3; ++a3) { const int cc = a3 * 512 + c; const float w0 = cw[cc], w1 = cw[1536 + cc], w2 = cw[3072 + cc], bs = cb[cc];
        const int dst = a3 == 0 ? O_ZA : (a3 == 1 ? O_G1 : O_G2);
        for (int p = tid; p < NB * L / 8; p += 512) { const int bb = p / (L / 8), s8 = (p % (L / 8)) * 8;
            const bf16_t* ur = UT + (size_t)cc * MT + (GRP ? MC + bb * 1024 : bb * 256) + s8;
            const u32x4 w = *(const u32x4*)ur; float u[10];
            u[0] = s8 > 0 ? bf2f(ur[-1]) : 0.f; u[9] = s8 + 8 < L ? bf2f(ur[8]) : 0.f;
            u[1] = lo16(w.x); u[2] = hi16(w.x); u[3] = lo16(w.y); u[4] = hi16(w.y); u[5] = lo16(w.z); u[6] = hi16(w.z); u[7] = lo16(w.w); u[8] = hi16(w.w);
            float y[8];
#pragma unroll
            for (int j = 0; j < 8; ++j) y[j] = w0 * u[j] + w1 * u[j + 1] + w2 * u[j + 2] + bs;
            *(LAS u32x4*)(lds + dst + bb * ZSTR + s8 * 2) = (u32x4){pk2(y[0], y[1]), pk2(y[2], y[3]), pk2(y[4], y[5]), pk2(y[6], y[7])}; } }
    __syncthreads();
    auto expand_hr = [&]() { for (int p = tid; p < 2 * L; p += 512) { const LAS bf16_t* rt = (const LAS bf16_t*)(lds + O_RT) + p;
            unsigned w[4];
#pragma unroll
            for (int k = 0; k < 4; ++k) { const unsigned a = p + 2 * k < 2 * L ? rt[2 * k] : 0, bq = p + 2 * k + 1 < 2 * L ? rt[2 * k + 1] : 0; w[k] = a | (bq << 16); }
            *(LAS u32x4*)(lds + O_HR + p * 16) = (u32x4){w[0], w[1], w[2], w[3]}; } };
    expand_hr();
    __syncthreads();
#pragma unroll 1
    for (int o = 0; o < 2; ++o) {
        const int zin = o == 0 ? O_ZA : O_ZB, gin = o == 0 ? O_G1 : O_G2;
        f32x4 acc[NTT];
#pragma unroll
        for (int i = 0; i < NTT; ++i) acc[i] = (f32x4){0.f, 0.f, 0.f, 0.f};
        const LAS unsigned char* zrow = lds + zin + (li & (NB - 1)) * ZSTR + lg * 16;
        const int rr = (-li) & 7;
#pragma unroll 2
        for (int sb = 0; sb < L / 32; ++sb) {
            const bf16x8 bfrag = *(const LAS bf16x8*)(zrow + sb * 64);
#pragma unroll
            for (int i = 0; i < NTT; ++i) { const int t0 = 16 * (wave + 8 * i); const int x0 = L - t0 + 32 * sb - li + 8 * lg;
                const bf16x8 afrag = *(const LAS bf16x8*)(lds + O_HR + x0 * 16);
                acc[i] = __builtin_amdgcn_mfma_f32_16x16x32_bf16(afrag, bfrag, acc[i], 0, 0, 0); }
        }
        (void)rr;
        const float skip = F.in[I_HSKIP][(size_t)l * 1024 + o * 512 + c];
        if (o == 0) stage_rt(1);
        if (li < NB) {
#pragma unroll
            for (int i = 0; i < NTT; ++i) { const int t = 16 * (wave + 8 * i) + 4 * lg;
                const u32x2 zw = *(const LAS u32x2*)(lds + zin + li * ZSTR + t * 2), gw = *(const LAS u32x2*)(lds + gin + li * ZSTR + t * 2);
                float y[4];
                y[0] = lo16(gw.x) * (acc[i][0] + lo16(zw.x) * skip); y[1] = hi16(gw.x) * (acc[i][1] + hi16(zw.x) * skip);
                y[2] = lo16(gw.y) * (acc[i][2] + lo16(zw.y) * skip); y[3] = hi16(gw.y) * (acc[i][3] + hi16(zw.y) * skip);
                if (o == 0) *(LAS u32x2*)(lds + O_ZB + li * ZSTR + t * 2) = (u32x2){pk2(y[0], y[1]), pk2(y[2], y[3])};
                else { bf16_t* Y = WSP(bf16_t, WS_YMIX) + (size_t)((GRP ? MC + li * 1024 : li * 256) + t) * DM + c;
#pragma unroll
                    for (int e = 0; e < 4; ++e) Y[(size_t)e * DM] = (bf16_t)f2bf(y[e]); } }
        }
        if (o == 0) { __syncthreads(); expand_hr(); __syncthreads(); }
    }
}
__device__ __forceinline__ void phase_hyena(Frame& F, int l) {
    for (int u = F.bid; u < 1024; u += F.G) { if (u < 512) hyena_unit<1>(F, l, u); else hyena_unit<0>(F, l, u - 512); }
    __syncthreads();
}

__global__ void __launch_bounds__(512, 2) fwd_kernel(Args args) {
    extern __shared__ __attribute__((aligned(16))) unsigned char lds_raw[];
    cg::grid_group grid = cg::this_grid();
    Frame F;
    F.lds = (LAS unsigned char*)lds_raw;
    F.G = gridDim.x; F.bid = blockIdx.x; F.in = args.in; F.out = args.out; F.ws = args.ws;

    for (int rep = 0; rep < REP_P0; ++rep) {
    p0_mod(F);
    p0_filters(F);
    __syncthreads();
    p0_weights(F);
    __syncthreads();
    }
    grid.sync();

    for (int l = 0; l < 2; ++l) {
        const float* xa = l == 0 ? F.in[I_XP] : WSP(float, WS_X2); const float* xb = l == 0 ? F.in[I_XS] : WSP(float, WS_X2); const int split = l == 0 ? MC : MT;
        const float* modl = WSP(float, WS_MOD) + (size_t)l * 9 * NMOD;
        phase_norm(F, l, xa, xb, split, F.in[I_LNMIX] + l * DM, 1 * DM, 0 * DM);
        grid.sync();
        { pg8::Gemms g; g.K = DM; g.A0 = WSP(bf16_t, WS_WINT) + (size_t)l * NT_ * DM; g.B0 = WSP(bf16_t, WS_XN); g.A1 = WSP(bf16_t, WS_XN); g.B1 = WSP(bf16_t, WS_WINN) + (size_t)l * NN_ * DM;
          pg8::MultiOrder S; S.init(F.G, F.bid, NT_, MT, MT, NN_);
          pg8::EpiStore E; E.O0 = WSP(bf16_t, WS_UT); E.ld0 = MT; E.O1 = WSP(bf16_t, WS_UN); E.ld1 = NN_;
          pg8::gemm_phase(F.lds, g, S, E); }
        grid.sync();
        phase_prep(F, l);
        grid.sync();
        { pg8::Gemms g; g.K = 384; g.A0 = WSP(bf16_t, WS_CQN); g.B0 = WSP(bf16_t, WS_WUQ) + (size_t)l * 1536 * 384; g.A1 = g.A0; g.B1 = g.B0;
          pg8::MultiOrder S; S.init(F.G, F.bid, MT, 1536, 0, 0);
          pg8::EpiStore E; E.O0 = E.O1 = WSP(bf16_t, WS_Q); E.ld0 = E.ld1 = 1536;
          pg8::gemm_phase(F.lds, g, S, E); }
        { pg8::Gemms g; g.K = 256; const bf16_t* ck = WSP(bf16_t, WS_CKVN) + (size_t)l * MKV * 256;
          g.A0 = ck; g.B0 = WSP(bf16_t, WS_WUK) + (size_t)l * 1024 * 256; g.A1 = WSP(bf16_t, WS_WUV) + (size_t)l * 1024 * 256; g.B1 = ck;
          pg8::MultiOrder S; S.init(F.G, F.bid, MKV, 1024, 1024, MKV);
          pg8::EpiStore E; E.O0 = WSP(bf16_t, WS_KN); E.ld0 = 1024; E.O1 = WSP(bf16_t, WS_VT); E.ld1 = MKV;
          pg8::gemm_phase(F.lds, g, S, E); }
        grid.sync();
        for (int rep = 0; rep < REP_ATTN; ++rep) phase_attn(F, l);
        for (int rep = 0; rep < REP_GLA; ++rep) phase_gla(F, l);
        for (int rep = 0; rep < REP_HY; ++rep) phase_hyena(F, l);
        grid.sync();
        phase_gla_combine(F, l);
        grid.sync();
        { pg8::Gemms g; g.K = DM; g.A0 = WSP(bf16_t, WS_YMIX); g.B0 = WSP(bf16_t, WS_WOUT) + (size_t)l * DM * DM; g.A1 = g.A0; g.B1 = g.B0;
          pg8::MultiOrder S; S.init(F.G, F.bid, MT, DM, 0, 0);
          pg8::EpiResGate E; E.base0 = xa; E.base1 = xb; E.split = split; E.out = WSP(float, WS_X1); E.mod = modl; E.goff = 2 * DM;
          pg8::gemm_phase(F.lds, g, S, E); }
        grid.sync();
        phase_norm(F, l, WSP(float, WS_X1), WSP(float, WS_X1), MT, F.in[I_LNFFN] + l * DM, 4 * DM, 3 * DM);
        grid.sync();
        { pg8::Gemms g; g.K = DM; g.A0 = WSP(bf16_t, WS_XN); g.B0 = WSP(bf16_t, WS_WF1) + (size_t)l * 2 * DFF * DM; g.A1 = g.A0; g.B1 = g.B0;
          pg8::MultiOrder S; S.init(F.G, F.bid, MT, 2 * DFF, 0, 0);
          pg8::EpiSwiGLU E; E.O = WSP(bf16_t, WS_H);
          pg8::gemm_phase(F.lds, g, S, E); }
        grid.sync();
        { pg8::Gemms g; g.K = DFF; g.A0 = WSP(bf16_t, WS_H); g.B0 = WSP(bf16_t, WS_WF2) + (size_t)l * DM * DFF; g.A1 = g.A0; g.B1 = g.B0;
          pg8::MultiOrder S; S.init(F.G, F.bid, MT, DM, 0, 0);
          pg8::EpiResGate E; E.base0 = WSP(float, WS_X1); E.base1 = E.base0; E.split = MT; E.out = WSP(float, WS_X2); E.mod = modl; E.goff = 5 * DM;
          pg8::gemm_phase(F.lds, g, S, E); }
        grid.sync();
    }
    phase_final(F, WSP(float, WS_X2), F.in[I_LNFIN]);
}

extern "C" void kernel_launch(void* const* d_in, const int* in_sizes, int n_in, void* d_out, int out_size, void* d_ws, size_t ws_size, hipStream_t stream) {
    static int grid = 0;
    if (grid == 0) {
        int dev = 0, cus = 0, per_cu = 0;
        if (n_in != 35 || ws_size < WS_END) { fprintf(stderr, "kernel_launch: unexpected n_in %d / ws %zu (need %zu)\n", n_in, ws_size, (size_t)WS_END); grid = -1; return; }
        (void)hipGetDevice(&dev);
        (void)hipDeviceGetAttribute(&cus, hipDeviceAttributeMultiprocessorCount, dev);
        (void)hipFuncSetAttribute((const void*)fwd_kernel, hipFuncAttributeMaxDynamicSharedMemorySize, LDS_BYTES);
        (void)hipOccupancyMaxActiveBlocksPerMultiprocessor(&per_cu, (const void*)fwd_kernel, 512, LDS_BYTES);
        if (per_cu < 1) { fprintf(stderr, "kernel_launch: occupancy query says %d blocks/CU\n", per_cu); per_cu = 1; }
        grid = cus;
    }
    if (grid < 0) return;
    Args a{};
    for (int i = 0; i < 35; ++i) a.in[i] = (const float*)d_in[i];
    a.out = (float*)d_out; a.ws = (unsigned char*)d_ws;
    void* kargs[] = {&a};
    hipError_t e = hipLaunchCooperativeKernel((const void*)fwd_kernel, dim3(grid), dim3(512), kargs, LDS_BYTES, stream);
    if (e != hipSuccess) fprintf(stderr, "cooperative launch failed: %s (grid %d)\n", hipGetErrorString(e), grid);
}
```

```cpp
#include <hip/hip_runtime.h>
#include <hip/hip_cooperative_groups.h>
#include <cstdio>
#include <cstdint>
namespace cg = cooperative_groups;
#ifndef REP_G1
#define REP_G1 1
#endif
#ifndef REP_G2
#define REP_G2 1
#endif
#ifndef REP_G3
#define REP_G3 1
#endif
#ifndef REP_G4
#define REP_G4 1
#endif
#ifndef REP_G5
#define REP_G5 1
#endif
#ifndef REP_NORM
#define REP_NORM 1
#endif
#ifndef REP_MISC
#define REP_MISC 1
#endif
#ifndef REP_SYNC
#define REP_SYNC 0
#endif
#ifndef REP_ATTN
#define REP_ATTN 1
#endif
#ifndef REP_GLA
#define REP_GLA 1
#endif
#ifndef REP_HY
#define REP_HY 1
#endif
#ifndef REP_P0
#define REP_P0 1
#endif

#define LAS __attribute__((address_space(3)))
typedef unsigned short bf16_t;
typedef short bf16x8 __attribute__((ext_vector_type(8)));
typedef short s16x4 __attribute__((ext_vector_type(4)));
typedef float f32x4 __attribute__((ext_vector_type(4)));
typedef float f32x2 __attribute__((ext_vector_type(2)));
typedef float f32x16 __attribute__((ext_vector_type(16)));
typedef unsigned u32x4 __attribute__((ext_vector_type(4)));
typedef unsigned u32x2 __attribute__((ext_vector_type(2)));

constexpr int DM = 2048, MC = 4096, ML = 8192, MT = MC + ML;
constexpr int NMOD = 6 * DM;
constexpr int DFF = 5632;
constexpr int NT_ = 2304, NN_ = 1792;
constexpr int MKV = MT + 2048;
constexpr float EPS = 1e-6f;
constexpr int UN_Q = 0, UN_K = 256, UN_G = 512, UN_CQ = 1024, UN_CKV = 1408, UN_KR = 1664, UN_AF = 1728, UN_AB = 1744;
constexpr int UT_HY = 0, UT_GK = 1536, UT_GV = 1792;
constexpr size_t O_Y = 0, O_CKV = (size_t)MT * DM, O_KR = O_CKV + 2097152, O_GF = O_KR + 524288, O_GB = O_GF + 1048576;

constexpr size_t al(size_t x) { return (x + 255) & ~(size_t)255; }
constexpr size_t WS_MOD = 0;
constexpr size_t WS_WINT = al(WS_MOD + 2 * 9 * NMOD * 4);
constexpr size_t WS_WINN = al(WS_WINT + (size_t)2 * NT_ * DM * 2);
constexpr size_t WS_WUQ = al(WS_WINN + (size_t)2 * NN_ * DM * 2);
constexpr size_t WS_WUK = al(WS_WUQ + (size_t)2 * 1536 * 384 * 2);
constexpr size_t WS_WUV = al(WS_WUK + (size_t)2 * 1024 * 256 * 2);
constexpr size_t WS_WOUT = al(WS_WUV + (size_t)2 * 1024 * 256 * 2);
constexpr size_t WS_WF1 = al(WS_WOUT + (size_t)2 * DM * DM * 2);
constexpr size_t WS_WF2 = al(WS_WF1 + (size_t)2 * 2 * DFF * DM * 2);
constexpr size_t WS_HF = al(WS_WF2 + (size_t)2 * DM * DFF * 2);
constexpr size_t HF_L = (size_t)2 * 512 * 512 + (size_t)2 * 512 * 2048;
constexpr size_t WS_XN = al(WS_HF + 2 * HF_L * 2);
constexpr size_t WS_CKVN = al(WS_XN + (size_t)MT * DM * 2);
constexpr size_t WS_KRB = al(WS_CKVN + (size_t)2 * MKV * 256 * 2);
constexpr size_t WS_YMIX = al(WS_KRB + (size_t)2 * MKV * 64 * 2);
constexpr size_t WS_X1 = al(WS_YMIX + (size_t)MT * DM * 2);
constexpr size_t WS_X2 = al(WS_X1 + (size_t)MT * DM * 4);
constexpr size_t WS_UT = al(WS_X2 + (size_t)MT * DM * 4);
constexpr size_t WS_UN = al(WS_UT + (size_t)NT_ * MT * 2);
constexpr size_t WS_CQN = al(WS_UN + (size_t)MT * NN_ * 2);
constexpr size_t WS_Q = al(WS_CQN + (size_t)MT * 384 * 2);
constexpr size_t WS_KN = al(WS_Q + (size_t)MT * 1536 * 2);
constexpr size_t WS_VT = al(WS_KN + (size_t)MKV * 1024 * 2);
constexpr size_t WS_OF = al(WS_VT + (size_t)1024 * MKV * 2);
constexpr size_t WS_OB = al(WS_OF + (size_t)MT * 512 * 4);
constexpr size_t WS_MIXEND = al(WS_OB + (size_t)MT * 512 * 4);
constexpr size_t WS_H = WS_UT;
constexpr size_t WS_CTL = WS_MIXEND;
constexpr size_t WS_END = WS_CTL + 65536;
static_assert(WS_H + (size_t)MT * DFF * 2 <= WS_MIXEND, "H overlay fits");

constexpr int LDS_BYTES = 147456;

__device__ __forceinline__ float bf2f(bf16_t v) { return __uint_as_float((unsigned)v << 16); }
__device__ __forceinline__ unsigned f2bf(float f) { unsigned u = __float_as_uint(f); return (u + 0x7fffu + ((u >> 16) & 1u)) >> 16; }
__device__ __forceinline__ unsigned pk2(float lo, float hi) { return f2bf(lo) | (f2bf(hi) << 16); }
__device__ __forceinline__ float lo16(unsigned w) { return __uint_as_float(w << 16); }
__device__ __forceinline__ float hi16(unsigned w) { return __uint_as_float(w & 0xffff0000u); }
__device__ __forceinline__ float wave_sum(float v) {
#pragma unroll
    for (int o = 1; o < 64; o <<= 1) v += __shfl_xor(v, o);
    return v;
}
__device__ __forceinline__ float sin_turns(float t) { return __builtin_amdgcn_sinf(t); }
__device__ __forceinline__ float cos_turns(float t) { return __builtin_amdgcn_cosf(t); }
__device__ __forceinline__ float sin_rad(float x) { float t = x * 0.15915494309189535f; t -= floorf(t); return __builtin_amdgcn_sinf(t); }
__device__ __forceinline__ float siluf(float x) { return x / (1.f + __expf(-x)); }

namespace pg8 {
constexpr int BM = 256, BK = 64, HALF = 128, HTB = HALF * BK * 2, STAGE_BYTES = 8 * HTB, NXCD = 8, WGM = 8;
__host__ __device__ __forceinline__ int lds_byte(int r, int c) { const int st = (r >> 4) * 2 + (c >> 5), rr = r & 15, cc = c & 31, ob = rr * 64 + cc * 2; return st * 1024 + (ob ^ (((ob >> 9) & 1) << 5)); }
__host__ __device__ __forceinline__ void stage_rc(int b, int& R, int& C) { const int st = b / 1024, sb = b % 1024, swz = sb ^ (((sb >> 9) & 1) << 5); R = (st >> 1) * 16 + swz / 64; C = (st & 1) * 32 + (swz % 64) / 2; }
__host__ __device__ __forceinline__ int perm32(int rho) { const int n = rho >> 4, i = rho & 15; return 8 * (i >> 2) + 4 * n + (i & 3); }

struct Unit { int pm, pn, gi; };
struct Gemms { const bf16_t* A0; const bf16_t* B0; const bf16_t* A1; const bf16_t* B1; int K; };

struct MultiOrder {
    int nM0, nN0, nM1, nN1, n0, nwg, G, c;
    __device__ __forceinline__ void init(int G_, int c_, int M0, int N0, int M1, int N1) { G = G_; c = c_; nM0 = M0 / BM; nN0 = N0 / BM; nM1 = M1 / BM; nN1 = N1 / BM; n0 = nM0 * nN0; nwg = n0 + nM1 * nN1; }
    __device__ __forceinline__ bool next(int i, Unit& u) const {
        const long L = (long)i * G + c; if (L >= nwg) return false;
        int wgid = (int)L; { const int q = nwg / NXCD, r = nwg % NXCD, xcd = wgid % NXCD, o = wgid / NXCD; wgid = (xcd < r ? xcd * (q + 1) : r * (q + 1) + (xcd - r) * q) + o; }
        const int s = wgid >= n0 ? 1 : 0;
        const int loc = wgid - (s ? n0 : 0);
        const int nm = s ? nM1 : nM0, nn = s ? nN1 : nN0;
        const int nig = WGM * nn, gid = loc / nig, fm = gid * WGM, gsz = (nm - fm) < WGM ? (nm - fm) : WGM;
        u.pm = fm + ((loc % nig) % gsz); u.pn = (loc % nig) / gsz; u.gi = s; return true;
    }
};

__device__ __forceinline__ unsigned cvt_pk_bf16(float lo, float hi) { unsigned r; asm volatile("v_cvt_pk_bf16_f32 %0, %1, %2" : "=v"(r) : "v"(lo), "v"(hi)); return r; }

struct EpiStore {
    static constexpr bool PERM = true;
    bf16_t* O0; bf16_t* O1; int ld0, ld1;
    __device__ __forceinline__ void operator()(const f32x4 (&acc)[2][2][4][2], const Unit& u, int wr, int wc, int fr, int fq) const {
        bf16_t* base = u.gi >= 1 ? O1 : O0; const int ld = u.gi >= 1 ? ld1 : ld0;
        const int row0 = u.pm * BM + wr * 64 + fr, col0 = u.pn * BM + wc * 32 + 8 * fq;
#pragma unroll
        for (int ai = 0; ai < 2; ++ai)
#pragma unroll
            for (int m = 0; m < 4; ++m) { bf16_t* rowp = base + (size_t)(row0 + ai * HALF + m * 16) * ld + col0;
#pragma unroll
                for (int bj = 0; bj < 2; ++bj) { const f32x4 v0 = acc[ai][bj][m][0], v1 = acc[ai][bj][m][1];
                    u32x4 w; w.x = cvt_pk_bf16(v0[0], v0[1]); w.y = cvt_pk_bf16(v0[2], v0[3]); w.z = cvt_pk_bf16(v1[0], v1[1]); w.w = cvt_pk_bf16(v1[2], v1[3]);
                    *(u32x4*)(rowp + bj * HALF) = w; } }
    }
};
struct EpiSwiGLU {
    static constexpr bool PERM = true;
    bf16_t* O;
    __device__ __forceinline__ void operator()(const f32x4 (&acc)[2][2][4][2], const Unit& u, int wr, int wc, int fr, int fq) const {
        const int row0 = u.pm * BM + wr * 64 + fr, col0 = u.pn * HALF + wc * 32 + 8 * fq;
#pragma unroll
        for (int ai = 0; ai < 2; ++ai)
#pragma unroll
            for (int m = 0; m < 4; ++m) { bf16_t* rowp = O + (size_t)(row0 + ai * HALF + m * 16) * DFF + col0;
                float h[8];
#pragma unroll
                for (int n = 0; n < 2; ++n)
#pragma unroll
                    for (int e = 0; e < 4; ++e) { const float g = acc[ai][0][m][n][e], up = acc[ai][1][m][n][e]; h[n * 4 + e] = g * __builtin_amdgcn_rcpf(1.f + __expf(-g)) * up; }
                u32x4 w; w.x = cvt_pk_bf16(h[0], h[1]); w.y = cvt_pk_bf16(h[2], h[3]); w.z = cvt_pk_bf16(h[4], h[5]); w.w = cvt_pk_bf16(h[6], h[7]);
                *(u32x4*)rowp = w; }
    }
};
struct EpiResGate {
    static constexpr bool PERM = false;
    const float* base0; const float* base1; int split; float* out; const float* mod; int goff;
    __device__ __forceinline__ void operator()(const f32x4 (&acc)[2][2][4][2], const Unit& u, int wr, int wc, int fr, int fq) const {
        const int r9 = u.pm < 16 ? 8 : ((u.pm - 16) >> 2);
        const float* gate = mod + (size_t)r9 * NMOD + goff;
        const int row0 = u.pm * BM + wr * 64 + fr, col0 = u.pn * BM + wc * 32 + 4 * fq;
        f32x4 gv[2][2];
#pragma unroll
        for (int bj = 0; bj < 2; ++bj)
#pragma unroll
            for (int n = 0; n < 2; ++n) gv[bj][n] = *(const f32x4*)(gate + col0 + bj * HALF + n * 16);
#pragma unroll
        for (int ai = 0; ai < 2; ++ai)
#pragma unroll
            for (int m = 0; m < 4; ++m) { const int row = row0 + ai * HALF + m * 16;
                const float* bp = (row < split ? base0 + (size_t)row * DM : base1 + (size_t)(row - split) * DM) + col0; float* op = out + (size_t)row * DM + col0;
#pragma unroll
                for (int bj = 0; bj < 2; ++bj)
#pragma unroll
                    for (int n = 0; n < 2; ++n) { const f32x4 b = *(const f32x4*)(bp + bj * HALF + n * 16); *(f32x4*)(op + bj * HALF + n * 16) = b + gv[bj][n] * acc[ai][bj][m][n]; } }
    }
};

template <class Epi, class Sched>
__device__ __forceinline__ void gemm_phase(LAS unsigned char* lds, const Gemms g, const Sched& S, const Epi& E) {
    int tid_ = threadIdx.x; asm volatile("" : "+v"(tid_));
    const int tid = tid_, wid = __builtin_amdgcn_readfirstlane(tid >> 6), lane = tid & 63, wr = wid >> 2, wc = wid & 3, fr = lane & 15, fq = lane >> 4;
    const int K = g.K, nt = K / BK;
    unsigned voffA[2], voffB[2];
#pragma unroll
    for (int i = 0; i < 2; ++i) { int R, C; stage_rc(tid * 16 + i * 8192, R, C); const int Rb = Epi::PERM ? ((R & ~31) + perm32(R & 31)) : R;
        voffA[i] = (unsigned)(R * K + C) * 2u; voffB[i] = (unsigned)(Rb * K + C) * 2u; }
    const size_t kstep = (size_t)(BK * 2);
    const size_t hstep = (size_t)HALF * K * 2;
    const size_t tstep = 2 * hstep;
    const unsigned ldsw = (unsigned)wid * 1024u;
    const int aoff = lds_byte(wr * 64 + fr, fq * 8), boff = lds_byte(wc * 32 + fr, fq * 8);
#define PG8_SA(b, h) (((b) * 2 + (h)) * HTB)
#define PG8_SB(b, h) ((4 + (b) * 2 + (h)) * HTB)
#define PG8_STAGE(bufoff, gbase, voff) do { _Pragma("unroll") for (int _i = 0; _i < 2; ++_i) \
        __builtin_amdgcn_global_load_lds((const unsigned*)((const char*)(gbase) + (voff)[_i]), (LAS unsigned*)(lds + (bufoff) + ldsw + _i * 8192), 16, 0, 0); } while (0)
#define PG8_LDA(dst, b, h) do { _Pragma("unroll") for (int m = 0; m < 4; ++m) _Pragma("unroll") for (int k = 0; k < 2; ++k) dst[m][k] = *(const LAS bf16x8*)(lds + PG8_SA(b, h) + aoff + m * 2048 + k * 1024); } while (0)
#define PG8_LDB(dst, b, h) do { _Pragma("unroll") for (int n = 0; n < 2; ++n) _Pragma("unroll") for (int k = 0; k < 2; ++k) dst[n][k] = *(const LAS bf16x8*)(lds + PG8_SB(b, h) + boff + n * 2048 + k * 1024); } while (0)
#define PG8_MMA(ai, bj, At, Bt) do { __builtin_amdgcn_s_setprio(1); _Pragma("unroll") for (int m = 0; m < 4; ++m) _Pragma("unroll") for (int n = 0; n < 2; ++n) _Pragma("unroll") for (int k = 0; k < 2; ++k) \
        acc[ai][bj][m][n] = __builtin_amdgcn_mfma_f32_16x16x32_bf16(Bt[n][k], At[m][k], acc[ai][bj][m][n], 0, 0, 0); __builtin_amdgcn_s_setprio(0); } while (0)
#define PG8_WAIT_V(n) asm volatile("s_waitcnt vmcnt(" #n ")" ::: "memory")
#define PG8_WAIT_L(n) asm volatile("s_waitcnt lgkmcnt(" #n ")" ::: "memory")
#define PG8_BAR __builtin_amdgcn_s_barrier()
#define PG8_SCHED __builtin_amdgcn_sched_barrier(0)
#define PG8_ABASE(u) ((const char*)((u).gi >= 1 ? g.A1 : g.A0) + (size_t)(u).pm * tstep)
#define PG8_BBASE(u) ((const char*)((u).gi >= 1 ? g.B1 : g.B0) + (size_t)(u).pn * tstep)
    Unit cur, nxt; int ui = 0;
    if (!S.next(0, cur)) return;
    f32x4 acc[2][2][4][2];
#pragma unroll
    for (int a = 0; a < 2; ++a)
#pragma unroll
        for (int b = 0; b < 2; ++b)
#pragma unroll
            for (int m = 0; m < 4; ++m)
#pragma unroll
                for (int n = 0; n < 2; ++n) acc[a][b][m][n] = (f32x4){0.f, 0.f, 0.f, 0.f};
    bf16x8 At[4][2], B0[2][2], B1[2][2];
    const char* cA = PG8_ABASE(cur); const char* cB = PG8_BBASE(cur);
    PG8_STAGE(PG8_SB(0, 0), cB, voffB); PG8_STAGE(PG8_SB(0, 1), cB + hstep, voffB); PG8_STAGE(PG8_SA(0, 0), cA, voffA); PG8_STAGE(PG8_SA(0, 1), cA + hstep, voffA);
    if (wr == 1) PG8_BAR;
    PG8_WAIT_V(2); PG8_BAR;
    PG8_STAGE(PG8_SB(1, 0), cB + kstep, voffB); PG8_STAGE(PG8_SA(1, 0), cA + kstep, voffA); PG8_STAGE(PG8_SB(1, 1), cB + hstep + kstep, voffB);
    PG8_WAIT_V(6); PG8_BAR;
    for (;;) {
        const bool has_next = S.next(ui + 1, nxt);
        const char* nA = has_next ? PG8_ABASE(nxt) : cA; const char* nB = has_next ? PG8_BBASE(nxt) : cB;
        for (int t = 0; t < nt; t += 2) {
            const bool last = (t == nt - 2);
            const char* a1 = cA + (size_t)(t + 1) * kstep;
            const char* a2 = last ? nA : cA + (size_t)(t + 2) * kstep; const char* b2 = last ? nB : cB + (size_t)(t + 2) * kstep;
            const char* a3 = a2 + kstep; const char* b3 = b2 + kstep;
            PG8_LDB(B0, 0, 0); PG8_LDB(B1, 0, 1); PG8_SCHED; PG8_LDA(At, 0, 0); PG8_STAGE(PG8_SA(1, 1), a1 + hstep, voffA);
            PG8_WAIT_V(8); PG8_WAIT_L(0); PG8_BAR; PG8_MMA(0, 0, At, B0); PG8_MMA(0, 1, At, B1); PG8_BAR; PG8_SCHED;
            PG8_LDA(At, 0, 1); PG8_STAGE(PG8_SB(0, 0), b2, voffB); PG8_STAGE(PG8_SB(0, 1), b2 + hstep, voffB); PG8_STAGE(PG8_SA(0, 0), a2, voffA);
            PG8_WAIT_V(8); PG8_WAIT_L(0); PG8_BAR; PG8_MMA(1, 0, At, B0); PG8_MMA(1, 1, At, B1); PG8_BAR; PG8_SCHED;
            PG8_LDB(B0, 1, 0); PG8_LDB(B1, 1, 1); PG8_SCHED; PG8_LDA(At, 1, 0); PG8_STAGE(PG8_SA(0, 1), a2 + hstep, voffA);
            PG8_WAIT_V(8); PG8_WAIT_L(0); PG8_BAR; PG8_MMA(0, 0, At, B0); PG8_MMA(0, 1, At, B1); PG8_BAR; PG8_SCHED;
            PG8_LDA(At, 1, 1); PG8_STAGE(PG8_SB(1, 0), b3, voffB); PG8_STAGE(PG8_SB(1, 1), b3 + hstep, voffB); PG8_STAGE(PG8_SA(1, 0), a3, voffA);
            PG8_WAIT_V(8); PG8_WAIT_L(0); PG8_BAR; PG8_MMA(1, 0, At, B0); PG8_MMA(1, 1, At, B1); PG8_BAR; PG8_SCHED;
        }
        if (wr == 0) PG8_BAR;
        E(acc, cur, wr, wc, fr, fq);
        if (!has_next) break;
#pragma unroll
        for (int a = 0; a < 2; ++a)
#pragma unroll
            for (int b = 0; b < 2; ++b)
#pragma unroll
                for (int m = 0; m < 4; ++m)
#pragma unroll
                    for (int n = 0; n < 2; ++n) acc[a][b][m][n] = (f32x4){0.f, 0.f, 0.f, 0.f};
        cur = nxt; cA = nA; cB = nB; ++ui;
        if (wr == 1) PG8_BAR;
    }
    PG8_WAIT_V(0);
    PG8_BAR;
#undef PG8_SA
#undef PG8_SB
#undef PG8_STAGE
#undef PG8_LDA
#undef PG8_LDB
#undef PG8_MMA
#undef PG8_WAIT_V
#undef PG8_WAIT_L
#undef PG8_BAR
#undef PG8_SCHED
#undef PG8_ABASE
#undef PG8_BBASE
}
}

#define XB_TMO      128
#define XB_XCNT(j)  (256  + 64 * (j))
#define XB_XSUB(j)  (1280 + 64 * (j))
#define XB_XGEN(j)  (2304 + 64 * (j))
#define XB_TOP      3328
#define XB_TOPGEN   3392
#define XCD_BAR_WORDS 3456
#define XB_SPIN_CAP (1u << 18)
__device__ __forceinline__ unsigned xb_ld(unsigned* p)              { return __hip_atomic_load(p, __ATOMIC_RELAXED, __HIP_MEMORY_SCOPE_AGENT); }
__device__ __forceinline__ unsigned xb_add(unsigned* p, unsigned v) { return __hip_atomic_fetch_add(p, v, __ATOMIC_RELAXED, __HIP_MEMORY_SCOPE_AGENT); }
__device__ __forceinline__ unsigned xb_xcc_id() { return (unsigned)__builtin_amdgcn_s_getreg((3 << 11) | 20) & 0xFu; }
#define XB_SPIN(cond, bar) do { unsigned _sp = 0; while (cond) { __builtin_amdgcn_s_sleep(1); \
    if ((++_sp & 255u) == 0u) { if (xb_ld(&(bar)[XB_TMO])) break; if (_sp > XB_SPIN_CAP) { atomicAdd(&(bar)[XB_TMO], 1u); break; } } } } while (0)
struct XcdBarrier { unsigned* bar; unsigned x; volatile LAS unsigned* st; };
__device__ __forceinline__ XcdBarrier xcd_barrier_post(unsigned* bar, volatile LAS unsigned* st) {
    XcdBarrier b; b.bar = bar; b.x = xb_xcc_id(); b.st = st;
    if (threadIdx.x == 0) (void)xb_add(&bar[XB_XCNT(b.x)], 1u);
    return b;
}
__device__ __forceinline__ void xcd_barrier_complete(unsigned* bar, unsigned x, unsigned& nloc, unsigned& nx) {
    const unsigned G = gridDim.x * gridDim.y * gridDim.z;
    unsigned sum, cnt, mine, sp = 0u;
    for (;;) {
        sum = 0u; cnt = 0u; mine = 0u;
#pragma unroll
        for (unsigned j = 0; j < 16; ++j) { const unsigned c = xb_ld(&bar[XB_XCNT(j)]); sum += c; cnt += (c > 0u) ? 1u : 0u; mine = (j == x) ? c : mine; }
        if (sum == G) break;
        __builtin_amdgcn_s_sleep(1);
        if ((++sp & 255u) == 0u) { if (xb_ld(&bar[XB_TMO])) break; if (sp > XB_SPIN_CAP) { atomicAdd(&bar[XB_TMO], 1u); break; } }
    }
    nloc = mine > 0u ? mine : 1u; nx = cnt > 0u ? cnt : 1u;
}
__device__ __forceinline__ void xcd_barrier(const XcdBarrier& b) {
    asm volatile("s_waitcnt vmcnt(0)" ::: "memory");
    __syncthreads();
    if (threadIdx.x == 0) {
        unsigned* bar = b.bar;
        __builtin_amdgcn_s_waitcnt(0);
        unsigned nloc = b.st[0], nx = b.st[1];
        if (nloc == 0u) { xcd_barrier_complete(bar, b.x, nloc, nx); b.st[0] = nloc; b.st[1] = nx; }
        const unsigned old = xb_add(&bar[XB_XSUB(b.x)], 1u);
        const unsigned gen = old / nloc;
        if (old + 1u == (gen + 1u) * nloc) {
            __builtin_amdgcn_fence(__ATOMIC_RELEASE, "agent");
            asm volatile("s_waitcnt vmcnt(0)" ::: "memory");
            const unsigned og = xb_add(&bar[XB_TOP], 1u);
            const unsigned tg = og / nx;
            if (og + 1u == (tg + 1u) * nx) xb_add(&bar[XB_TOPGEN], 1u);
            else XB_SPIN(xb_ld(&bar[XB_TOPGEN]) == tg, bar);
            __builtin_amdgcn_fence(__ATOMIC_ACQUIRE, "agent");
            xb_add(&bar[XB_XGEN(b.x)], 1u);
            asm volatile("s_waitcnt vmcnt(0)" ::: "memory");
        } else {
            XB_SPIN(xb_ld(&bar[XB_XGEN(b.x)]) == gen, bar);
            __builtin_amdgcn_fence(__ATOMIC_ACQUIRE, "agent");
            asm volatile("s_waitcnt vmcnt(0)" ::: "memory");
        }
    }
    __syncthreads();
}

struct Args { const float* in[35]; float* out; unsigned char* ws; int pad0, pad1; };
enum { I_XP = 0, I_XS, I_CCKV, I_CKR, I_SGF, I_SGB, I_C, I_CCTX, I_WMOD, I_BMOD, I_LNMIX, I_WIN, I_HCW, I_HCB, I_HW1, I_HB1, I_HFREQ, I_HW2, I_HB2, I_HW3, I_HSKIP,
       I_WAF, I_BAF, I_WAB, I_BAB, I_GNORM, I_QNORM, I_WUQ, I_KVNORM, I_WUKV, I_WOUT, I_LNFFN, I_WF1, I_WF2, I_LNFIN };

struct Frame {
    LAS unsigned char* lds;
    int G, bid;
    const float* const* in; float* out; unsigned char* ws;
};
struct Ids { int tid, lane, wave; };
__device__ __forceinline__ Ids get_ids() { int t = threadIdx.x; asm volatile("" : "+v"(t)); Ids r; r.tid = t; r.lane = t & 63; r.wave = __builtin_amdgcn_readfirstlane(t >> 6); return r; }
#define WSP(T, off) ((T*)(F.ws + (off)))

__device__ __forceinline__ void transpose_item(const float* W, int ldn, int k0, int n0, bf16_t* WT, int ldk, int row0, LAS float* scr, int lane) {
    float v[32];
#pragma unroll
    for (int i = 0; i < 32; ++i) { const int kk = 2 * i + (lane >> 5); v[i] = W[(size_t)(k0 + kk) * ldn + n0 + (lane & 31)]; }
#pragma unroll
    for (int i = 0; i < 32; ++i) { const int kk = 2 * i + (lane >> 5); scr[kk * 33 + (lane & 31)] = v[i]; }
    asm volatile("s_waitcnt lgkmcnt(0)" ::: "memory");
    const int c = lane & 7;
#pragma unroll
    for (int j = 0; j < 4; ++j) { const int n = (lane >> 3) + 8 * j; const LAS float* s = scr + (8 * c) * 33 + n;
        u32x4 o; o.x = pk2(s[0 * 33], s[1 * 33]); o.y = pk2(s[2 * 33], s[3 * 33]); o.z = pk2(s[4 * 33], s[5 * 33]); o.w = pk2(s[6 * 33], s[7 * 33]);
        *(u32x4*)(WT + (size_t)(row0 + n) * ldk + k0 + 8 * c) = o; }
    asm volatile("s_waitcnt lgkmcnt(0)" ::: "memory");
}

__device__ __forceinline__ void p0_weights(Frame& F) {
    const Ids I = get_ids();
    LAS float* scr = (LAS float*)(F.lds + I.wave * 16384);
    const int gw = F.bid * 8 + I.wave, NGW = F.G * 8;
    constexpr int I_IN = 32 * 119, I_UQ = 6 * 48, I_UKV = 4 * 64, I_OUT = 32 * 64, I_F1 = 32 * 352, I_F2 = 88 * 64, I_L = I_IN + I_UQ + I_UKV + I_OUT + I_F1 + I_F2;
    for (int it = gw; it < 2 * I_L; it += NGW) {
        const int l = it / I_L; int r = it % I_L;
        if (r < I_IN) {
            const int kb = r / 119, nb = r % 119, n0 = nb * 32; const float* W = F.in[I_WIN] + (size_t)l * DM * 3808;
            bf16_t* WT = WSP(bf16_t, WS_WINT) + (size_t)l * NT_ * DM; bf16_t* WN = WSP(bf16_t, WS_WINN) + (size_t)l * NN_ * DM;
            if (n0 < 1536) transpose_item(W, 3808, kb * 64, n0, WT, DM, n0, scr, I.lane);
            else if (n0 < 1792) transpose_item(W, 3808, kb * 64, n0, WN, DM, UN_Q + (n0 - 1536), scr, I.lane);
            else if (n0 < 2048) { transpose_item(W, 3808, kb * 64, n0, WT, DM, UT_GK + (n0 - 1792), scr, I.lane); transpose_item(W, 3808, kb * 64, n0, WN, DM, UN_K + (n0 - 1792), scr, I.lane); }
            else if (n0 < 2560) transpose_item(W, 3808, kb * 64, n0, WT, DM, UT_GV + (n0 - 2048), scr, I.lane);
            else if (n0 < 3072) transpose_item(W, 3808, kb * 64, n0, WN, DM, UN_G + (n0 - 2560), scr, I.lane);
            else if (n0 < 3104) transpose_item(W, 3808, kb * 64, n0, WN, DM, UN_AF + (n0 - 3072), scr, I.lane);
            else if (n0 < 3488) transpose_item(W, 3808, kb * 64, n0, WN, DM, UN_CQ + (n0 - 3104), scr, I.lane);
            else if (n0 < 3744) transpose_item(W, 3808, kb * 64, n0, WN, DM, UN_CKV + (n0 - 3488), scr, I.lane);
            else transpose_item(W, 3808, kb * 64, n0, WN, DM, UN_KR + (n0 - 3744), scr, I.lane);
            continue; }
        r -= I_IN;
        if (r < I_UQ) { const int kb = r / 48, nb = r % 48; transpose_item(F.in[I_WUQ] + (size_t)l * 384 * 1536, 1536, kb * 64, nb * 32, WSP(bf16_t, WS_WUQ) + (size_t)l * 1536 * 384, 384, nb * 32, scr, I.lane); continue; }
        r -= I_UQ;
        if (r < I_UKV) { const int kb = r / 64, nb = r % 64, n0 = nb * 32, h = n0 >> 8, j = n0 & 255;
            if (j < 128) transpose_item(F.in[I_WUKV] + (size_t)l * 256 * 2048, 2048, kb * 64, n0, WSP(bf16_t, WS_WUK) + (size_t)l * 1024 * 256, 256, h * 128 + j, scr, I.lane);
            else transpose_item(F.in[I_WUKV] + (size_t)l * 256 * 2048, 2048, kb * 64, n0, WSP(bf16_t, WS_WUV) + (size_t)l * 1024 * 256, 256, h * 128 + (j - 128), scr, I.lane);
            continue; }
        r -= I_UKV;
        if (r < I_OUT) { const int kb = r / 64, nb = r % 64; transpose_item(F.in[I_WOUT] + (size_t)l * DM * DM, DM, kb * 64, nb * 32, WSP(bf16_t, WS_WOUT) + (size_t)l * DM * DM, DM, nb * 32, scr, I.lane); continue; }
        r -= I_OUT;
        if (r < I_F1) { const int kb = r / 352, nb = r % 352, n0 = nb * 32; const int up = n0 >= DFF, j = up ? n0 - DFF : n0;
            transpose_item(F.in[I_WF1] + (size_t)l * DM * 2 * DFF, 2 * DFF, kb * 64, n0, WSP(bf16_t, WS_WF1) + (size_t)l * 2 * DFF * DM, DM, 256 * (j >> 7) + (up ? 128 : 0) + (j & 127), scr, I.lane); continue; }
        r -= I_F1;
        { const int kb = r / 64, nb = r % 64; transpose_item(F.in[I_WF2] + (size_t)l * DFF * DM, DM, kb * 64, nb * 32, WSP(bf16_t, WS_WF2) + (size_t)l * DM * DFF, DFF, nb * 32, scr, I.lane); }
    }
    { const int gt = F.bid * 512 + I.tid, NT = F.G * 512;
      for (int i = gt; i < 2 * 8192; i += NT) { const int l = i / 8192, e = i % 8192; *(u32x4*)(WSP(bf16_t, WS_WINN) + (size_t)l * NN_ * DM + (size_t)1760 * DM + e * 8) = (u32x4){0u, 0u, 0u, 0u}; } }
    { const int gt = F.bid * 512 + I.tid, NT = F.G * 512;
      for (int i = gt; i < 2 * 2048 * 64; i += NT) { const int l = i / (2048 * 64), e = i % (2048 * 64), rr = e >> 6, c4 = (e & 63) * 4, b = rr >> 8, j = rr & 255;
          const f32x4 v = *(const f32x4*)(F.in[I_CCKV] + ((size_t)(b * 2 + l) * 256 + j) * 256 + c4);
          *(u32x2*)(WSP(bf16_t, WS_CKVN) + ((size_t)l * MKV + MT + rr) * 256 + c4) = (u32x2){pk2(v[0], v[1]), pk2(v[2], v[3])}; }
      for (int i = gt; i < 2 * 2048 * 16; i += NT) { const int l = i / (2048 * 16), e = i % (2048 * 16), rr = e >> 4, c4 = (e & 15) * 4, b = rr >> 8, j = rr & 255;
          const f32x4 v = *(const f32x4*)(F.in[I_CKR] + ((size_t)(b * 2 + l) * 256 + j) * 64 + c4);
          *(u32x2*)(WSP(bf16_t, WS_KRB) + ((size_t)l * MKV + MT + rr) * 64 + c4) = (u32x2){pk2(v[0], v[1]), pk2(v[2], v[3])}; } }
}

__device__ __forceinline__ void p0_mod(Frame& F) {
    const Ids I = get_ids();
    LAS float* sc = (LAS float*)F.lds;
    LAS float* red = (LAS float*)(F.lds + 9 * 2048 * 4);
    for (int i = I.tid; i < 9 * 2048; i += 512) { const int r = i >> 11, k = i & 2047; const float c = r < 8 ? F.in[I_C][r * 2048 + k] : F.in[I_CCTX][k]; sc[i] = siluf(c); }
    __syncthreads();
    for (int it = F.bid; it < 2 * 384; it += F.G) {
        const int l = it / 384, n0 = (it % 384) * 32, col = n0 + (I.lane & 31), kp = I.lane >> 5;
        const float* W = F.in[I_WMOD] + (size_t)l * DM * NMOD + col;
        float acc[9];
#pragma unroll
        for (int r = 0; r < 9; ++r) acc[r] = 0.f;
        const int kbase = I.wave * 256;
#pragma unroll 8
        for (int i = 0; i < 128; ++i) { const int k = kbase + 2 * i + kp; const float w = W[(size_t)k * NMOD];
#pragma unroll
            for (int r = 0; r < 9; ++r) acc[r] += sc[r * 2048 + k] * w; }
#pragma unroll
        for (int r = 0; r < 9; ++r) { acc[r] += __shfl_xor(acc[r], 32); if (I.lane < 32) red[(I.wave * 9 + r) * 32 + I.lane] = acc[r]; }
        __syncthreads();
        if (I.tid < 288) { const int r = I.tid >> 5, c = I.tid & 31; float s = 0.f;
#pragma unroll
            for (int w = 0; w < 8; ++w) s += red[(w * 9 + r) * 32 + c];
            WSP(float, WS_MOD)[((size_t)l * 9 + r) * NMOD + n0 + c] = s + F.in[I_BMOD][(size_t)l * NMOD + n0 + c]; }
        __syncthreads();
    }
}

__device__ __forceinline__ void p0_filters(Frame& F) {
    const Ids I = get_ids();
    LAS float* scr = (LAS float*)(F.lds + 90112 + I.wave * 6144);
    LAS float* zb = scr; LAS float* h1 = scr + 8 * 33; LAS float* h2 = h1 + 8 * 64;
    const int gw = F.bid * 8 + I.wave, NGW = F.G * 8, lane = I.lane;
    for (int it = gw; it < 2 * 160; it += NGW) {
        const int l = it / 160, r = it % 160, grp = r >= 32, tb = grp ? r - 32 : r, L = grp ? 1024 : 256, t0 = tb * 8;
        const float* w1 = F.in[I_HW1] + l * 33 * 64; const float* b1 = F.in[I_HB1] + l * 64; const float* fr = F.in[I_HFREQ] + l * 128;
        const float* w2 = F.in[I_HW2] + l * 64 * 64; const float* b2 = F.in[I_HB2] + l * 64; const float* w3 = F.in[I_HW3] + (size_t)l * 64 * 2048;
        for (int e = lane; e < 8 * 33; e += 64) { const int tt = e / 33, j = e % 33, t = t0 + tt; float z;
            if (j == 0) z = (float)t / (float)(L - 1);
            else { const int band = (j - 1) & 15; const float f = 1e-4f + (float)band * ((15.f - 1e-4f) / 15.f); float turns = f * (float)t / (float)L; turns -= floorf(turns);
                   z = j <= 16 ? cos_turns(turns) : -sin_turns(turns); }
            zb[e] = z; }
        asm volatile("s_waitcnt lgkmcnt(0)" ::: "memory");
        { float a[8];
#pragma unroll
          for (int tt = 0; tt < 8; ++tt) a[tt] = b1[lane];
          for (int i = 0; i < 33; ++i) { const float w = w1[i * 64 + lane];
#pragma unroll
              for (int tt = 0; tt < 8; ++tt) a[tt] += zb[tt * 33 + i] * w; }
          const float f0 = fr[lane];
#pragma unroll
          for (int tt = 0; tt < 8; ++tt) h1[tt * 64 + lane] = sin_rad(f0 * a[tt]); }
        asm volatile("s_waitcnt lgkmcnt(0)" ::: "memory");
        { float a[8];
#pragma unroll
          for (int tt = 0; tt < 8; ++tt) a[tt] = b2[lane];
          for (int i = 0; i < 64; ++i) { const float w = w2[i * 64 + lane];
#pragma unroll
              for (int tt = 0; tt < 8; ++tt) a[tt] += h1[tt * 64 + i] * w; }
          const float f1 = fr[64 + lane];
#pragma unroll
          for (int tt = 0; tt < 8; ++tt) h2[tt * 64 + lane] = sin_rad(f1 * a[tt]); }
        asm volatile("s_waitcnt lgkmcnt(0)" ::: "memory");
        bf16_t* HF = WSP(bf16_t, WS_HF) + (size_t)l * HF_L + (grp ? (size_t)2 * 512 * 512 : 0);
        for (int q = 0; q < 32; ++q) { const int n = q * 64 + lane, side = n >> 10, o = (n >> 9) & 1, c = n & 511;
            float a[8];
#pragma unroll
            for (int tt = 0; tt < 8; ++tt) a[tt] = 0.f;
            for (int i = 0; i < 64; ++i) { const float w = w3[(size_t)i * 2048 + n];
#pragma unroll
                for (int tt = 0; tt < 8; ++tt) a[tt] += h2[tt * 64 + i] * w; }
            const float delta = 3.0701134573f + (float)c * ((15.3505672866f - 3.0701134573f) / 511.f);
            bf16_t* dst = HF + ((size_t)o * 512 + c) * (2 * L) + L;
#pragma unroll
            for (int tt = 0; tt < 8; ++tt) { const int t = t0 + tt; const float tl = (float)t / (float)(L - 1); const float v = a[tt] * __expf(-tl * delta);
                if (side == 0) dst[-t] = (bf16_t)f2bf(v); else if (t > 0) dst[t] = (bf16_t)f2bf(v); else dst[-L] = 0; } }
        asm volatile("s_waitcnt lgkmcnt(0)" ::: "memory");
    }
}

__device__ __forceinline__ void phase_norm(Frame& F, int l, const float* x0, const float* x1, int split, const float* ln, int sc_off, int sh_off) {
    const Ids I = get_ids();
    const int gw = F.bid * 8 + I.wave, NGW = F.G * 8;
    bf16_t* XN = WSP(bf16_t, WS_XN);
    for (int m = gw; m < MT; m += NGW) {
        const float* xr = m < split ? x0 + (size_t)m * DM : x1 + (size_t)(m - split) * DM;
        const int r9 = m < MC ? 8 : ((m - MC) >> 10);
        const float* mod = WSP(float, WS_MOD) + ((size_t)l * 9 + r9) * NMOD;
        f32x4 v[8]; float ss = 0.f;
#pragma unroll
        for (int j = 0; j < 8; ++j) { v[j] = *(const f32x4*)(xr + 4 * (64 * j + I.lane)); ss += (v[j][0] * v[j][0] + v[j][1] * v[j][1]) + (v[j][2] * v[j][2] + v[j][3] * v[j][3]); }
        const float rstd = 1.f / sqrtf(wave_sum(ss) * (1.f / DM) + EPS);
#pragma unroll
        for (int j = 0; j < 8; ++j) { const int col = 4 * (64 * j + I.lane);
            const f32x4 g = *(const f32x4*)(ln + col), sc = *(const f32x4*)(mod + sc_off + col), sh = *(const f32x4*)(mod + sh_off + col);
            const f32x4 y = v[j] * rstd * g * (sc + 1.f) + sh;
            *(u32x2*)(XN + (size_t)m * DM + col) = (u32x2){pk2(y[0], y[1]), pk2(y[2], y[3])}; }
    }
}
__device__ __forceinline__ void phase_final(Frame& F, const float* x, const float* ln) {
    const Ids I = get_ids();
    const int gw = F.bid * 8 + I.wave, NGW = F.G * 8;
    for (int m = gw; m < MT; m += NGW) {
        const float* xr = x + (size_t)m * DM;
        f32x4 v[8]; float ss = 0.f;
#pragma unroll
        for (int j = 0; j < 8; ++j) { v[j] = *(const f32x4*)(xr + 4 * (64 * j + I.lane)); ss += (v[j][0] * v[j][0] + v[j][1] * v[j][1]) + (v[j][2] * v[j][2] + v[j][3] * v[j][3]); }
        const float rstd = 1.f / sqrtf(wave_sum(ss) * (1.f / DM) + EPS);
#pragma unroll
        for (int j = 0; j < 8; ++j) { const int col = 4 * (64 * j + I.lane); const f32x4 g = *(const f32x4*)(ln + col);
            *(f32x4*)(F.out + O_Y + (size_t)m * DM + col) = v[j] * rstd * g; }
    }
}

__device__ __forceinline__ void phase_prep(Frame& F, int l) {
    const Ids I = get_ids();
    const int gw = F.bid * 8 + I.wave, NGW = F.G * 8, lane = I.lane;
    const bf16_t* UN = WSP(bf16_t, WS_UN);
    const float* qn = F.in[I_QNORM] + l * 384; const float* kvn = F.in[I_KVNORM] + l * 256;
    for (int m = gw; m < MT; m += NGW) {
        const bf16_t* ur = UN + (size_t)m * NN_;
        { const unsigned* p = (const unsigned*)(ur + UN_CQ + 6 * lane); const unsigned w0 = p[0], w1 = p[1], w2 = p[2];
          float v[6] = {lo16(w0), hi16(w0), lo16(w1), hi16(w1), lo16(w2), hi16(w2)}; float ss = 0.f;
#pragma unroll
          for (int i = 0; i < 6; ++i) ss += v[i] * v[i];
          const float rstd = 1.f / sqrtf(wave_sum(ss) * (1.f / 384.f) + EPS);
          unsigned* o = (unsigned*)(WSP(bf16_t, WS_CQN) + (size_t)m * 384 + 6 * lane);
#pragma unroll
          for (int i = 0; i < 3; ++i) o[i] = pk2(v[2 * i] * rstd * qn[6 * lane + 2 * i], v[2 * i + 1] * rstd * qn[6 * lane + 2 * i + 1]); }
        { const u32x2 w = *(const u32x2*)(ur + UN_CKV + 4 * lane); float v[4] = {lo16(w.x), hi16(w.x), lo16(w.y), hi16(w.y)};
          const float ss = v[0] * v[0] + v[1] * v[1] + v[2] * v[2] + v[3] * v[3];
          const float rstd = 1.f / sqrtf(wave_sum(ss) * (1.f / 256.f) + EPS);
          const f32x4 g = *(const f32x4*)(kvn + 4 * lane); const f32x4 y = {v[0] * rstd * g[0], v[1] * rstd * g[1], v[2] * rstd * g[2], v[3] * rstd * g[3]};
          *(u32x2*)(WSP(bf16_t, WS_CKVN) + ((size_t)l * MKV + m) * 256 + 4 * lane) = (u32x2){pk2(y[0], y[1]), pk2(y[2], y[3])};
          if (m < MC) { const int b = m >> 8, t = m & 255; *(f32x4*)(F.out + O_CKV + ((size_t)(b * 2 + l) * 256 + t) * 256 + 4 * lane) = y; } }
        { const float v = bf2f(ur[UN_KR + lane]); float o = v;
          if (m < MC) { const int b = m >> 8, t = m & 255; F.out[O_KR + ((size_t)(b * 2 + l) * 256 + t) * 64 + lane] = v; }
          else { const int t = (m - MC) & 1023; const int pos = lane < 32 ? (t >> 6) : (t & 63); const int i = lane & 15;
                 const float inv = __builtin_amdgcn_exp2f(-(float)i * (13.287712379549449f / 16.f));
                 float turns = (float)pos * inv * 0.15915494309189535f; turns -= floorf(turns);
                 const float cs = cos_turns(turns), sn = sin_turns(turns); const float pv = __shfl_xor(v, 16);
                 o = (lane & 16) ? (pv * sn + v * cs) : (v * cs - pv * sn); }
          WSP(bf16_t, WS_KRB)[((size_t)l * MKV + m) * 64 + lane] = (bf16_t)f2bf(o); }
    }
}

constexpr int KSTR = 400, VSTR = 136;
constexpr int KTILE = 64 * KSTR, VTILE = 128 * VSTR, ABUF = KTILE + VTILE;
__device__ __forceinline__ void attn_unit(Frame& F, int l, int grp, int b, int h, int qb) {
    const Ids I = get_ids();
    const int tid = I.tid, lane = I.lane, wave = I.wave, r32 = lane & 31, hi = lane >> 5;
    const bf16_t* Q = WSP(bf16_t, WS_Q); const bf16_t* KN = WSP(bf16_t, WS_KN); const bf16_t* VT = WSP(bf16_t, WS_VT); const bf16_t* KR = WSP(bf16_t, WS_KRB) + (size_t)l * MKV * 64;
    const int qrow0 = grp ? MC + b * 1024 + qb * 256 : b * 256;
    const int ntile = grp ? 20 : 4;
    const int qrow = qrow0 + wave * 32 + r32;
    bf16x8 qr[12];
#pragma unroll
    for (int s = 0; s < 12; ++s) qr[s] = *(const bf16x8*)(Q + (size_t)qrow * 1536 + h * 192 + 16 * s + 8 * hi);
    if (grp) {
        const int t = (qrow - MC) & 1023;
#pragma unroll
        for (int half = 0; half < 2; ++half) { const int pos = half ? (t & 63) : (t >> 6);
#pragma unroll
            for (int j = 0; j < 8; ++j) { const int i = 8 * hi + j; const float inv = __builtin_amdgcn_exp2f(-(float)i * (13.287712379549449f / 16.f));
                float turns = (float)pos * inv * 0.15915494309189535f; turns -= floorf(turns); const float cs = cos_turns(turns), sn = sin_turns(turns);
                const float x1 = bf2f((bf16_t)qr[8 + 2 * half][j]), x2 = bf2f((bf16_t)qr[9 + 2 * half][j]);
                qr[8 + 2 * half][j] = (short)f2bf(x1 * cs - x2 * sn); qr[9 + 2 * half][j] = (short)f2bf(x1 * sn + x2 * cs); } }
    }
    f32x16 o[4];
#pragma unroll
    for (int d = 0; d < 4; ++d) o[d] = (f32x16){};
    float m_run = -1e30f, l_run = 0.f;
    constexpr float C = 0.07216878364870322f * 1.4426950408889634f;
    u32x4 sk0, sk1, skr, sv0, sv1;
    auto key_base = [&](int tb) -> int { return grp ? (tb < 16 ? MC + b * 1024 + tb * 64 : MT + b * 256 + (tb - 16) * 64) : b * 256 + tb * 64; };
    auto gload = [&](int tb) { const int kb = key_base(tb);
        { const int e = tid, row = e >> 4, ch = e & 15; sk0 = *(const u32x4*)(KN + (size_t)(kb + row) * 1024 + h * 128 + ch * 8); }
        { const int e = tid + 512, row = e >> 4, ch = e & 15; sk1 = *(const u32x4*)(KN + (size_t)(kb + row) * 1024 + h * 128 + ch * 8); }
        { const int row = tid >> 3, ch = tid & 7; skr = *(const u32x4*)(KR + (size_t)(kb + row) * 64 + ch * 8); }
        { const int e = tid, row = e >> 3, ch = e & 7; sv0 = *(const u32x4*)(VT + (size_t)(h * 128 + row) * MKV + kb + ch * 8); }
        { const int e = tid + 512, row = e >> 3, ch = e & 7; sv1 = *(const u32x4*)(VT + (size_t)(h * 128 + row) * MKV + kb + ch * 8); } };
    auto lstore = [&](int buf) { LAS unsigned char* kb = F.lds + buf * ABUF; LAS unsigned char* vb = kb + KTILE;
        { const int e = tid, row = e >> 4, ch = e & 15; *(LAS u32x4*)(kb + row * KSTR + ch * 16) = sk0; }
        { const int e = tid + 512, row = e >> 4, ch = e & 15; *(LAS u32x4*)(kb + row * KSTR + ch * 16) = sk1; }
        { const int row = tid >> 3, ch = tid & 7; *(LAS u32x4*)(kb + row * KSTR + 256 + ch * 16) = skr; }
        { const int e = tid, row = e >> 3, ch = e & 7; *(LAS u32x2*)(vb + row * VSTR + ch * 16) = (u32x2){sv0.x, sv0.y}; *(LAS u32x2*)(vb + row * VSTR + ch * 16 + 8) = (u32x2){sv0.z, sv0.w}; }
        { const int e = tid + 512, row = e >> 3, ch = e & 7; *(LAS u32x2*)(vb + row * VSTR + ch * 16) = (u32x2){sv1.x, sv1.y}; *(LAS u32x2*)(vb + row * VSTR + ch * 16 + 8) = (u32x2){sv1.z, sv1.w}; } };
    __syncthreads();
    gload(0); lstore(0); __syncthreads();
    for (int tb = 0; tb < ntile; ++tb) {
        const int buf = tb & 1;
        if (tb + 1 < ntile) gload(tb + 1);
        LAS unsigned char* kb = F.lds + buf * ABUF; LAS unsigned char* vb = kb + KTILE;
        f32x16 p0 = (f32x16){}, p1 = (f32x16){};
#pragma unroll
        for (int s = 0; s < 12; ++s) {
            const bf16x8 k0 = *(const LAS bf16x8*)(kb + r32 * KSTR + (16 * s + 8 * hi) * 2);
            const bf16x8 k1 = *(const LAS bf16x8*)(kb + (32 + r32) * KSTR + (16 * s + 8 * hi) * 2);
            p0 = __builtin_amdgcn_mfma_f32_32x32x16_bf16(k0, qr[s], p0, 0, 0, 0);
            p1 = __builtin_amdgcn_mfma_f32_32x32x16_bf16(k1, qr[s], p1, 0, 0, 0);
        }
        float pmax = p0[0];
#pragma unroll
        for (int r = 1; r < 16; ++r) pmax = fmaxf(pmax, p0[r]);
#pragma unroll
        for (int r = 0; r < 16; ++r) pmax = fmaxf(pmax, p1[r]);
        pmax = fmaxf(pmax, __shfl_xor(pmax, 32));
        const float mn = fmaxf(m_run, pmax); const float alpha = __builtin_amdgcn_exp2f((m_run - mn) * C); m_run = mn;
        const float mnC = -mn * C; float ps = 0.f;
#pragma unroll
        for (int r = 0; r < 16; ++r) { p0[r] = __builtin_amdgcn_exp2f(fmaf(p0[r], C, mnC)); p1[r] = __builtin_amdgcn_exp2f(fmaf(p1[r], C, mnC)); ps += p0[r] + p1[r]; }
        l_run = l_run * alpha + ps;
#pragma unroll
        for (int d = 0; d < 4; ++d)
#pragma unroll
            for (int r = 0; r < 16; ++r) o[d][r] *= alpha;
        bf16x8 pb[4];
#pragma unroll
        for (int ks = 0; ks < 4; ++ks) { u32x4 w;
#pragma unroll
            for (int jj = 0; jj < 4; ++jj) { const int r = (ks & 1) * 8 + 2 * jj; const float a = ks < 2 ? p0[r] : p1[r], bq = ks < 2 ? p0[r + 1] : p1[r + 1]; w[jj] = pg8::cvt_pk_bf16(a, bq); }
            pb[ks] = __builtin_bit_cast(bf16x8, w); }
#pragma unroll
        for (int d = 0; d < 4; ++d)
#pragma unroll
            for (int ks = 0; ks < 4; ++ks) { const LAS unsigned char* vp = vb + (32 * d + r32) * VSTR + (16 * ks + 4 * hi) * 2;
                const s16x4 lo = *(const LAS s16x4*)vp, hh = *(const LAS s16x4*)(vp + 16);
                const bf16x8 va = (bf16x8){lo[0], lo[1], lo[2], lo[3], hh[0], hh[1], hh[2], hh[3]};
                o[d] = __builtin_amdgcn_mfma_f32_32x32x16_bf16(va, pb[ks], o[d], 0, 0, 0); }
        if (tb + 1 < ntile) lstore(buf ^ 1);
        __syncthreads();
    }
    const float lt = l_run + __shfl_xor(l_run, 32); const float rl = 1.f / lt;
    bf16_t* yo = WSP(bf16_t, WS_YMIX) + (size_t)qrow * DM + 1024 + h * 128;
#pragma unroll
    for (int d = 0; d < 4; ++d)
#pragma unroll
        for (int g4 = 0; g4 < 4; ++g4) { const int dv = 32 * d + 8 * g4 + 4 * hi;
            *(u32x2*)(yo + dv) = (u32x2){pk2(o[d][4 * g4] * rl, o[d][4 * g4 + 1] * rl), pk2(o[d][4 * g4 + 2] * rl, o[d][4 * g4 + 3] * rl)}; }
}
__device__ __forceinline__ void phase_attn(Frame& F, int l) {
    for (int u = F.bid; u < 384; u += F.G) {
        if (u < 256) attn_unit(F, l, 1, u >> 5, (u >> 2) & 7, u & 3);
        else { const int v = u - 256; attn_unit(F, l, 0, v >> 3, v & 7, 0); }
    }
    __syncthreads();
}

__device__ __forceinline__ void gla_unit(Frame& F, int l, int grp, int b, int h, int dir) {
    const Ids I = get_ids();
    const int tid = I.tid, lane = I.lane, wave = I.wave, li = lane & 15, lg = lane >> 4;
    constexpr int SQ = 144;
    constexpr int O_QD = 0, O_KI = 9216, O_KET = 18432, O_ATT = 27648, O_VT = 36864, O_AF = 55296, O_TOT = 59392, O_DEC = 61440;
    const int L = grp ? 1024 : 256, row0 = grp ? MC + b * 1024 : b * 256, NCH = L / 64;
    const bf16_t* UN = WSP(bf16_t, WS_UN); const bf16_t* UT = WSP(bf16_t, WS_UT);
    const float* wa = (dir ? F.in[I_WAB] : F.in[I_WAF]) + l * 16 * 256 + h * 64 + lane; const float ba_d = ((dir ? F.in[I_BAB] : F.in[I_BAF]) + l * 256 + h * 64)[lane];
    const int afo = dir ? UN_AB : UN_AF;
    float* Oo = WSP(float, dir ? WS_OB : WS_OF);
    LAS unsigned char* lds = F.lds;
    float war[16];
#pragma unroll
    for (int r = 0; r < 16; ++r) war[r] = wa[r * 256];
    f32x4 S[4];
    if (grp) { const float* st = (dir ? F.in[I_SGB] : F.in[I_SGF]) + ((size_t)((b * 2 + l) * 4 + h) * 64) * 128 + 16 * wave + li;
#pragma unroll
        for (int td = 0; td < 4; ++td)
#pragma unroll
            for (int r = 0; r < 4; ++r) S[td][r] = st[(size_t)(16 * td + 4 * lg + r) * 128]; }
    else {
#pragma unroll
        for (int td = 0; td < 4; ++td) S[td] = (f32x4){0.f, 0.f, 0.f, 0.f}; }
#pragma unroll 1
    for (int cc = 0; cc < NCH; ++cc) {
        const int n = dir ? NCH - 1 - cc : cc, tb = row0 + 64 * n;
        __syncthreads();
#pragma unroll
        for (int e2 = 0; e2 < 2; ++e2) { const int e = tid + 512 * e2, i = e >> 4, r = e & 15; ((LAS float*)(lds + O_AF))[e] = bf2f(UN[(size_t)(tb + i) * NN_ + afo + r]); }
#pragma unroll
        for (int p2 = 0; p2 < 2; ++p2) { const int p = tid + 512 * p2, dv = p >> 3, c8 = (p & 7) * 8;
            *(LAS u32x4*)(lds + O_VT + dv * SQ + c8 * 2) = *(const u32x4*)(UT + (size_t)(UT_GV + h * 128 + dv) * MT + tb + c8); }
        float qv[8], kv[8];
#pragma unroll
        for (int m = 0; m < 8; ++m) { const bf16_t* ur = UN + (size_t)(tb + 8 * wave + m) * NN_ + h * 64 + lane; qv[m] = bf2f(ur[UN_Q]) * 0.125f; kv[m] = bf2f(ur[UN_K]); }
        __syncthreads();
        float g[8];
#pragma unroll
        for (int m = 0; m < 8; ++m) { const LAS f32x4* ap = (const LAS f32x4*)(lds + O_AF + (8 * wave + m) * 64); float x = ba_d;
#pragma unroll
            for (int r4 = 0; r4 < 4; ++r4) { const f32x4 a4 = ap[r4]; x += a4[0] * war[4 * r4] + a4[1] * war[4 * r4 + 1] + a4[2] * war[4 * r4 + 2] + a4[3] * war[4 * r4 + 3]; }
            g[m] = (fminf(x, 0.f) - __logf(1.f + __expf(-fabsf(x)))) * (1.f / 16.f); }
        if (dir == 0) {
#pragma unroll
            for (int m = 1; m < 8; ++m) g[m] += g[m - 1];
        } else {
#pragma unroll
            for (int m = 6; m >= 0; --m) g[m] += g[m + 1];
        }
        ((LAS float*)(lds + O_TOT))[wave * 64 + lane] = dir == 0 ? g[7] : g[0];
        __syncthreads();
        float off = 0.f, gtot = 0.f;
#pragma unroll
        for (int w2 = 0; w2 < 8; ++w2) { const float tv = ((const LAS float*)(lds + O_TOT))[w2 * 64 + lane]; gtot += tv; if (dir == 0 ? (w2 < wave) : (w2 > wave)) off += tv; }
        { unsigned kw[4];
#pragma unroll
          for (int m = 0; m < 8; ++m) { const float G = g[m] + off; const float eg = __expf(G), eng = __expf(-G), ee = __expf(gtot - G);
              ((LAS bf16_t*)(lds + O_QD + (8 * wave + m) * SQ))[lane] = (bf16_t)f2bf(qv[m] * eg);
              ((LAS bf16_t*)(lds + O_KI + (8 * wave + m) * SQ))[lane] = (bf16_t)f2bf(kv[m] * eng);
              const unsigned hv = f2bf(kv[m] * ee); if (m & 1) kw[m >> 1] |= hv << 16; else kw[m >> 1] = hv; }
          *(LAS u32x4*)(lds + O_KET + lane * SQ + wave * 16) = (u32x4){kw[0], kw[1], kw[2], kw[3]};
          if (wave == 0) ((LAS float*)(lds + O_DEC))[lane] = __expf(gtot); }
        __syncthreads();
        { const int ti = wave >> 1;
#pragma unroll
          for (int t2 = 0; t2 < 2; ++t2) { const int tj = 2 * (wave & 1) + t2; f32x4 c = (f32x4){0.f, 0.f, 0.f, 0.f};
              const bool live = dir == 0 ? (tj <= ti) : (tj >= ti);
              if (live) {
#pragma unroll
                  for (int kk = 0; kk < 2; ++kk) { const bf16x8 af = *(const LAS bf16x8*)(lds + O_KI + (16 * tj + li) * SQ + (32 * kk + 8 * lg) * 2);
                      const bf16x8 bfr = *(const LAS bf16x8*)(lds + O_QD + (16 * ti + li) * SQ + (32 * kk + 8 * lg) * 2);
                      c = __builtin_amdgcn_mfma_f32_16x16x32_bf16(af, bfr, c, 0, 0, 0); }
                  if (tj == ti) { const int ii = li;
#pragma unroll
                      for (int r = 0; r < 4; ++r) { const int jj = 4 * lg + r; const bool keep = dir == 0 ? (jj <= ii) : (jj >= ii); if (!keep) c[r] = 0.f; } } }
              *(LAS u32x2*)(lds + O_ATT + (16 * ti + li) * SQ + (16 * tj + 4 * lg) * 2) = (u32x2){pk2(c[0], c[1]), pk2(c[2], c[3])}; } }
        __syncthreads();
        { bf16x8 bv[2];
#pragma unroll
          for (int kk = 0; kk < 2; ++kk) bv[kk] = *(const LAS bf16x8*)(lds + O_VT + (16 * wave + li) * SQ + (32 * kk + 8 * lg) * 2);
          bf16x8 bs[2];
#pragma unroll
          for (int kk = 0; kk < 2; ++kk) { const u32x4 w4 = (u32x4){pk2(S[2 * kk][0], S[2 * kk][1]), pk2(S[2 * kk][2], S[2 * kk][3]), pk2(S[2 * kk + 1][0], S[2 * kk + 1][1]), pk2(S[2 * kk + 1][2], S[2 * kk + 1][3])};
              bs[kk] = __builtin_bit_cast(bf16x8, w4); }
#pragma unroll
          for (int ti = 0; ti < 4; ++ti) { f32x4 acc = (f32x4){0.f, 0.f, 0.f, 0.f};
#pragma unroll
              for (int kk = 0; kk < 2; ++kk) { const bf16x8 af = *(const LAS bf16x8*)(lds + O_ATT + (16 * ti + li) * SQ + (32 * kk + 8 * lg) * 2);
                  acc = __builtin_amdgcn_mfma_f32_16x16x32_bf16(af, bv[kk], acc, 0, 0, 0); }
#pragma unroll
              for (int kk = 0; kk < 2; ++kk) { const LAS unsigned char* qp = lds + O_QD + (16 * ti + li) * SQ + (32 * kk + 4 * lg) * 2;
                  const s16x4 lo = *(const LAS s16x4*)qp, hh = *(const LAS s16x4*)(qp + 32);
                  const bf16x8 af = (bf16x8){lo[0], lo[1], lo[2], lo[3], hh[0], hh[1], hh[2], hh[3]};
                  acc = __builtin_amdgcn_mfma_f32_16x16x32_bf16(af, bs[kk], acc, 0, 0, 0); }
              float* op = Oo + (size_t)(tb + 16 * ti + 4 * lg) * 512 + h * 128 + 16 * wave + li;
#pragma unroll
              for (int r = 0; r < 4; ++r) op[(size_t)r * 512] = acc[r]; }
#pragma unroll
          for (int td = 0; td < 4; ++td) { const f32x4 dc = *(const LAS f32x4*)(lds + O_DEC + (16 * td + 4 * lg) * 4); f32x4 c = S[td] * dc;
#pragma unroll
              for (int kk = 0; kk < 2; ++kk) { const bf16x8 af = *(const LAS bf16x8*)(lds + O_KET + (16 * td + li) * SQ + (32 * kk + 8 * lg) * 2);
                  c = __builtin_amdgcn_mfma_f32_16x16x32_bf16(af, bv[kk], c, 0, 0, 0); }
              S[td] = c; } }
    }
    if (!grp) { float* so = F.out + (dir ? O_GB : O_GF) + ((size_t)((b * 2 + l) * 4 + h) * 64) * 128 + 16 * wave + li;
#pragma unroll
        for (int td = 0; td < 4; ++td)
#pragma unroll
            for (int r = 0; r < 4; ++r) so[(size_t)(16 * td + 4 * lg + r) * 128] = S[td][r]; }
}
__device__ __forceinline__ void phase_gla(Frame& F, int l) {
    for (int u = F.bid; u < 192; u += F.G) {
        if (u < 64) gla_unit(F, l, 1, u >> 3, (u >> 1) & 3, u & 1);
        else { const int v = u - 64; gla_unit(F, l, 0, v >> 3, (v >> 1) & 3, v & 1); }
    }
    __syncthreads();
}
__device__ __forceinline__ void phase_gla_combine(Frame& F, int l) {
    const Ids I = get_ids();
    const int gw = F.bid * 8 + I.wave, NGW = F.G * 8, lane = I.lane;
    const float* gn = F.in[I_GNORM] + l * 128;
    for (int m = gw; m < MT; m += NGW) {
        const float* pf = WSP(float, WS_OF) + (size_t)m * 512 + 8 * lane; const float* pb = WSP(float, WS_OB) + (size_t)m * 512 + 8 * lane;
        const f32x4 a0 = *(const f32x4*)pf, a1 = *(const f32x4*)(pf + 4), b0 = *(const f32x4*)pb, b1 = *(const f32x4*)(pb + 4);
        float o[8] = {a0[0] + b0[0], a0[1] + b0[1], a0[2] + b0[2], a0[3] + b0[3], a1[0] + b1[0], a1[1] + b1[1], a1[2] + b1[2], a1[3] + b1[3]};
        float ss = 0.f;
#pragma unroll
        for (int i = 0; i < 8; ++i) ss += o[i] * o[i];
        ss += __shfl_xor(ss, 1); ss += __shfl_xor(ss, 2); ss += __shfl_xor(ss, 4); ss += __shfl_xor(ss, 8);
        const float rstd = 1.f / sqrtf(ss * (1.f / 128.f) + EPS);
        const u32x4 gw4 = *(const u32x4*)(WSP(bf16_t, WS_UN) + (size_t)m * NN_ + UN_G + 8 * lane);
        const float gg[8] = {lo16(gw4.x), hi16(gw4.x), lo16(gw4.y), hi16(gw4.y), lo16(gw4.z), hi16(gw4.z), lo16(gw4.w), hi16(gw4.w)};
        const int dv0 = (8 * lane) & 127; float y[8];
#pragma unroll
        for (int i = 0; i < 8; ++i) y[i] = o[i] * rstd * gn[dv0 + i] * siluf(gg[i]);
        *(u32x4*)(WSP(bf16_t, WS_YMIX) + (size_t)m * DM + 512 + 8 * lane) = (u32x4){pk2(y[0], y[1]), pk2(y[2], y[3]), pk2(y[4], y[5]), pk2(y[6], y[7])};
    }
}

template <int GRP> __device__ __forceinline__ void hyena_unit(Frame& F, int l, int c) {
    const Ids I = get_ids();
    constexpr int L = GRP ? 1024 : 256, NB = GRP ? 8 : 16, NTT = L / 128, ZSTR = 2 * L + 16;
    constexpr int O_HR = 0, O_RT = 2 * L * 16, O_ZA = O_RT + 4 * L, O_ZB = O_ZA + NB * ZSTR, O_G1 = O_ZB + NB * ZSTR, O_G2 = O_G1 + NB * ZSTR;
    static_assert(O_G2 + NB * ZSTR <= 131072, "hyena LDS");
    const int tid = I.tid, lane = I.lane, wave = I.wave, li = lane & 15, lg = lane >> 4;
    const bf16_t* UT = WSP(bf16_t, WS_UT);
    const float* cw = F.in[I_HCW] + (size_t)l * 3 * 1536; const float* cb = F.in[I_HCB] + (size_t)l * 1536;
    const bf16_t* RF = WSP(bf16_t, WS_HF) + (size_t)l * HF_L + (GRP ? (size_t)2 * 512 * 512 : 0);
    LAS unsigned char* lds = F.lds;
    __syncthreads();
    auto stage_rt = [&](int o) { if (tid < 2 * L / 8) *(LAS u32x4*)(lds + O_RT + tid * 16) = *(const u32x4*)(RF + ((size_t)o * 512 + c) * (2 * L) + tid * 8); };
    stage_rt(0);
#pragma unroll
    for (int a3 = 0; a3 < 3; ++a3) { const int cc = a3 * 512 + c; const float w0 = cw[cc], w1 = cw[1536 + cc], w2 = cw[3072 + cc], bs = cb[cc];
        const int dst = a3 == 0 ? O_ZA : (a3 == 1 ? O_G1 : O_G2);
        for (int p = tid; p < NB * L / 8; p += 512) { const int bb = p / (L / 8), s8 = (p % (L / 8)) * 8;
            const bf16_t* ur = UT + (size_t)cc * MT + (GRP ? MC + bb * 1024 : bb * 256) + s8;
            const u32x4 w = *(const u32x4*)ur; float u[10];
            u[0] = s8 > 0 ? bf2f(ur[-1]) : 0.f; u[9] = s8 + 8 < L ? bf2f(ur[8]) : 0.f;
            u[1] = lo16(w.x); u[2] = hi16(w.x); u[3] = lo16(w.y); u[4] = hi16(w.y); u[5] = lo16(w.z); u[6] = hi16(w.z); u[7] = lo16(w.w); u[8] = hi16(w.w);
            float y[8];
#pragma unroll
            for (int j = 0; j < 8; ++j) y[j] = w0 * u[j] + w1 * u[j + 1] + w2 * u[j + 2] + bs;
            *(LAS u32x4*)(lds + dst + bb * ZSTR + s8 * 2) = (u32x4){pk2(y[0], y[1]), pk2(y[2], y[3]), pk2(y[4], y[5]), pk2(y[6], y[7])}; } }
    __syncthreads();
    auto expand_hr = [&]() { for (int p = tid; p < 2 * L; p += 512) { const LAS bf16_t* rt = (const LAS bf16_t*)(lds + O_RT) + p;
            unsigned w[4];
#pragma unroll
            for (int k = 0; k < 4; ++k) { const unsigned a = p + 2 * k < 2 * L ? rt[2 * k] : 0, bq = p + 2 * k + 1 < 2 * L ? rt[2 * k + 1] : 0; w[k] = a | (bq << 16); }
            *(LAS u32x4*)(lds + O_HR + p * 16) = (u32x4){w[0], w[1], w[2], w[3]}; } };
    expand_hr();
    __syncthreads();
#pragma unroll 1
    for (int o = 0; o < 2; ++o) {
        const int zin = o == 0 ? O_ZA : O_ZB, gin = o == 0 ? O_G1 : O_G2;
        f32x4 acc[NTT];
#pragma unroll
        for (int i = 0; i < NTT; ++i) acc[i] = (f32x4){0.f, 0.f, 0.f, 0.f};
        const LAS unsigned char* zrow = lds + zin + (li & (NB - 1)) * ZSTR + lg * 16;
        const int rr = (-li) & 7;
#pragma unroll 2
        for (int sb = 0; sb < L / 32; ++sb) {
            const bf16x8 bfrag = *(const LAS bf16x8*)(zrow + sb * 64);
#pragma unroll
            for (int i = 0; i < NTT; ++i) { const int t0 = 16 * (wave + 8 * i); const int x0 = L - t0 + 32 * sb - li + 8 * lg;
                const bf16x8 afrag = *(const LAS bf16x8*)(lds + O_HR + x0 * 16);
                acc[i] = __builtin_amdgcn_mfma_f32_16x16x32_bf16(afrag, bfrag, acc[i], 0, 0, 0); }
        }
        (void)rr;
        const float skip = F.in[I_HSKIP][(size_t)l * 1024 + o * 512 + c];
        if (o == 0) stage_rt(1);
        if (li < NB) {
#pragma unroll
            for (int i = 0; i < NTT; ++i) { const int t = 16 * (wave + 8 * i) + 4 * lg;
                const u32x2 zw = *(const LAS u32x2*)(lds + zin + li * ZSTR + t * 2), gw = *(const LAS u32x2*)(lds + gin + li * ZSTR + t * 2);
                float y[4];
                y[0] = lo16(gw.x) * (acc[i][0] + lo16(zw.x) * skip); y[1] = hi16(gw.x) * (acc[i][1] + hi16(zw.x) * skip);
                y[2] = lo16(gw.y) * (acc[i][2] + lo16(zw.y) * skip); y[3] = hi16(gw.y) * (acc[i][3] + hi16(zw.y) * skip);
                if (o == 0) *(LAS u32x2*)(lds + O_ZB + li * ZSTR + t * 2) = (u32x2){pk2(y[0], y[1]), pk2(y[2], y[3])};
                else { bf16_t* Y = WSP(bf16_t, WS_YMIX) + (size_t)((GRP ? MC + li * 1024 : li * 256) + t) * DM + c;
#pragma unroll
                    for (int e = 0; e < 4; ++e) Y[(size_t)e * DM] = (bf16_t)f2bf(y[e]); } }
        }
        if (o == 0) { __syncthreads(); expand_hr(); __syncthreads(); }
    }
}
__device__ __forceinline__ void phase_hyena(Frame& F, int l) {
    for (int u = F.bid; u < 1024; u += F.G) { if (u < 512) hyena_unit<1>(F, l, u); else hyena_unit<0>(F, l, u - 512); }
    __syncthreads();
}

__global__ void __launch_bounds__(512, 2) fwd_kernel(Args args) {
    extern __shared__ __attribute__((aligned(16))) unsigned char lds_raw[];
    cg::grid_group grid = cg::this_grid();
    Frame F;
    F.lds = (LAS unsigned char*)lds_raw;
    F.G = gridDim.x; F.bid = blockIdx.x; F.in = args.in; F.out = args.out; F.ws = args.ws;
    volatile LAS unsigned* bst = (volatile LAS unsigned*)(F.lds + LDS_BYTES - 16);
    if (threadIdx.x < 4) bst[threadIdx.x] = 0u;
    if (blockIdx.x == 0) for (int i = threadIdx.x; i < XCD_BAR_WORDS; i += 512) WSP(unsigned, WS_CTL)[i] = 0u;
    __syncthreads();

    for (int rep = 0; rep < REP_P0; ++rep) {
    p0_mod(F);
    p0_filters(F);
    __syncthreads();
    p0_weights(F);
    __syncthreads();
    }
    grid.sync();
    const XcdBarrier xbar = xcd_barrier_post(WSP(unsigned, WS_CTL), bst);
#define GSYNC() xcd_barrier(xbar)

    for (int l = 0; l < 2; ++l) {
        const float* xa = l == 0 ? F.in[I_XP] : WSP(float, WS_X2); const float* xb = l == 0 ? F.in[I_XS] : WSP(float, WS_X2); const int split = l == 0 ? MC : MT;
        const float* modl = WSP(float, WS_MOD) + (size_t)l * 9 * NMOD;
        for (int rep = 0; rep < REP_NORM; ++rep) phase_norm(F, l, xa, xb, split, F.in[I_LNMIX] + l * DM, 1 * DM, 0 * DM);
        for (int rep = 0; rep < REP_SYNC; ++rep) GSYNC();
        GSYNC();
        { pg8::Gemms g; g.K = DM; g.A0 = WSP(bf16_t, WS_WINT) + (size_t)l * NT_ * DM; g.B0 = WSP(bf16_t, WS_XN); g.A1 = WSP(bf16_t, WS_XN); g.B1 = WSP(bf16_t, WS_WINN) + (size_t)l * NN_ * DM;
          pg8::MultiOrder S; S.init(F.G, F.bid, NT_, MT, MT, NN_);
          pg8::EpiStore E; E.O0 = WSP(bf16_t, WS_UT); E.ld0 = MT; E.O1 = WSP(bf16_t, WS_UN); E.ld1 = NN_;
          for (int rep = 0; rep < REP_G1; ++rep) pg8::gemm_phase(F.lds, g, S, E); }
        GSYNC();
        for (int rep = 0; rep < REP_MISC; ++rep) phase_prep(F, l);
        GSYNC();
        { pg8::Gemms g; g.K = 384; g.A0 = WSP(bf16_t, WS_CQN); g.B0 = WSP(bf16_t, WS_WUQ) + (size_t)l * 1536 * 384; g.A1 = g.A0; g.B1 = g.B0;
          pg8::MultiOrder S; S.init(F.G, F.bid, MT, 1536, 0, 0);
          pg8::EpiStore E; E.O0 = E.O1 = WSP(bf16_t, WS_Q); E.ld0 = E.ld1 = 1536;
          for (int rep = 0; rep < REP_G2; ++rep) pg8::gemm_phase(F.lds, g, S, E); }
        { pg8::Gemms g; g.K = 256; const bf16_t* ck = WSP(bf16_t, WS_CKVN) + (size_t)l * MKV * 256;
          g.A0 = ck; g.B0 = WSP(bf16_t, WS_WUK) + (size_t)l * 1024 * 256; g.A1 = WSP(bf16_t, WS_WUV) + (size_t)l * 1024 * 256; g.B1 = ck;
          pg8::MultiOrder S; S.init(F.G, F.bid, MKV, 1024, 1024, MKV);
          pg8::EpiStore E; E.O0 = WSP(bf16_t, WS_KN); E.ld0 = 1024; E.O1 = WSP(bf16_t, WS_VT); E.ld1 = MKV;
          for (int rep = 0; rep < REP_G2; ++rep) pg8::gemm_phase(F.lds, g, S, E); }
        GSYNC();
        for (int rep = 0; rep < REP_ATTN; ++rep) phase_attn(F, l);
        for (int rep = 0; rep < REP_GLA; ++rep) phase_gla(F, l);
        for (int rep = 0; rep < REP_HY; ++rep) phase_hyena(F, l);
        GSYNC();
        for (int rep = 0; rep < REP_MISC; ++rep) phase_gla_combine(F, l);
        GSYNC();
        { pg8::Gemms g; g.K = DM; g.A0 = WSP(bf16_t, WS_YMIX); g.B0 = WSP(bf16_t, WS_WOUT) + (size_t)l * DM * DM; g.A1 = g.A0; g.B1 = g.B0;
          pg8::MultiOrder S; S.init(F.G, F.bid, MT, DM, 0, 0);
          pg8::EpiResGate E; E.base0 = xa; E.base1 = xb; E.split = split; E.out = WSP(float, WS_X1); E.mod = modl; E.goff = 2 * DM;
          for (int rep = 0; rep < REP_G3; ++rep) pg8::gemm_phase(F.lds, g, S, E); }
        GSYNC();
        for (int rep = 0; rep < REP_NORM; ++rep) phase_norm(F, l, WSP(float, WS_X1), WSP(float, WS_X1), MT, F.in[I_LNFFN] + l * DM, 4 * DM, 3 * DM);
        GSYNC();
        { pg8::Gemms g; g.K = DM; g.A0 = WSP(bf16_t, WS_XN); g.B0 = WSP(bf16_t, WS_WF1) + (size_t)l * 2 * DFF * DM; g.A1 = g.A0; g.B1 = g.B0;
          pg8::MultiOrder S; S.init(F.G, F.bid, MT, 2 * DFF, 0, 0);
          pg8::EpiSwiGLU E; E.O = WSP(bf16_t, WS_H);
          for (int rep = 0; rep < REP_G4; ++rep) pg8::gemm_phase(F.lds, g, S, E); }
        GSYNC();
        { pg8::Gemms g; g.K = DFF; g.A0 = WSP(bf16_t, WS_H); g.B0 = WSP(bf16_t, WS_WF2) + (size_t)l * DM * DFF; g.A1 = g.A0; g.B1 = g.B0;
          pg8::MultiOrder S; S.init(F.G, F.bid, MT, DM, 0, 0);
          pg8::EpiResGate E; E.base0 = WSP(float, WS_X1); E.base1 = E.base0; E.split = MT; E.out = WSP(float, WS_X2); E.mod = modl; E.goff = 5 * DM;
          for (int rep = 0; rep < REP_G5; ++rep) pg8::gemm_phase(F.lds, g, S, E); }
        GSYNC();
    }
    phase_final(F, WSP(float, WS_X2), F.in[I_LNFIN]);
}

extern "C" void kernel_launch(void* const* d_in, const int* in_sizes, int n_in, void* d_out, int out_size, void* d_ws, size_t ws_size, hipStream_t stream) {
    static int grid = 0;
    if (grid == 0) {
        int dev = 0, cus = 0, per_cu = 0;
        if (n_in != 35 || ws_size < WS_END) { fprintf(stderr, "kernel_launch: unexpected n_in %d / ws %zu (need %zu)\n", n_in, ws_size, (size_t)WS_END); grid = -1; return; }
        (void)hipGetDevice(&dev);
        (void)hipDeviceGetAttribute(&cus, hipDeviceAttributeMultiprocessorCount, dev);
        (void)hipFuncSetAttribute((const void*)fwd_kernel, hipFuncAttributeMaxDynamicSharedMemorySize, LDS_BYTES);
        (void)hipOccupancyMaxActiveBlocksPerMultiprocessor(&per_cu, (const void*)fwd_kernel, 512, LDS_BYTES);
        if (per_cu < 1) { fprintf(stderr, "kernel_launch: occupancy query says %d blocks/CU\n", per_cu); per_cu = 1; }
        grid = cus;
    }
    if (grid < 0) return;
    Args a{};
    for (int i = 0; i < 35; ++i) a.in[i] = (const float*)d_in[i];
    a.out = (float*)d_out; a.ws = (unsigned char*)d_ws;
    void* kargs[] = {&a};
    hipError_t e = hipLaunchCooperativeKernel((const void*)fwd_kernel, dim3(grid), dim3(512), kargs, LDS_BYTES, stream);
    if (e != hipSuccess) fprintf(stderr, "cooperative launch failed: %s (grid %d)\n", hipGetErrorString(e), grid);
}
```
